# Optimizing an MI355X kernel written in HIP

```python
import jax, jax.numpy as jnp
from jax import lax
import numpy as np

D_MODEL = 1024
BATCH = 2
SEQ = 8192
DEPTH = 2

GRID_W = 64
CTX_LEN = 256
N_EVEN = (DEPTH + 1) // 2
N_ODD = DEPTH // 2
BLOCK = 128
NORM_EPS = 1e-6
ROPE_THETA = 10000.0
NEG_INF = -1e30
F32 = jnp.float32

HQ_A = 8
HKV_A = 2
DH_A = 64
WINDOW = 128
H_B = 4
DK_B = 128
DV_B = 128
CONV_K = 5
CHUNK = 64
HQ_C = 8
HKV_C = 2
DH_C = 128
N_EXPERTS = 16
CAP_FACTOR = 2
EXPERT_FF = 2048

A_Q = HQ_A * DH_A
A_KV = HKV_A * DH_A
A_COLS = A_Q + 2 * A_KV
B_QK = H_B * DK_B
B_V = H_B * DV_B
B_CONV = 2 * B_QK + B_V
B_COLS = B_CONV + B_V + 2 * H_B + 2 * H_B
IN_AB = A_COLS + B_COLS
OUT_AB = A_Q + B_V
C_Q = HQ_C * DH_C
C_KV = HKV_C * DH_C
IN_C = C_Q + 2 * C_KV
OUT_C = C_Q

kernel_name = "hybrid_diffusion_swa_gdn_gqa_ecmoe"


def rms_norm(x, gain):
    xf = x.astype(F32)
    y = xf * lax.rsqrt(jnp.mean(xf * xf, axis=-1, keepdims=True) + NORM_EPS)
    return (y * gain.astype(F32)).astype(x.dtype)


def l2_norm(x):
    xf = x.astype(F32)
    return xf * lax.rsqrt(jnp.sum(xf * xf, axis=-1, keepdims=True) + NORM_EPS)


def modulate(h, shift, scale):
    return h * (1 + scale) + shift


def axial_rope_tables(rows, head_dim):
    n = rows * GRID_W
    t = jnp.arange(n)
    row = (t // GRID_W).astype(F32)
    col = (t % GRID_W).astype(F32)
    quarter = head_dim // 4
    inv = ROPE_THETA ** (-jnp.arange(quarter, dtype=F32) / quarter)
    ang = jnp.stack([row[:, None] * inv, col[:, None] * inv], axis=1)
    return jnp.cos(ang), jnp.sin(ang)


def apply_axial_rope(x, cos, sin):
    B, n, H, hd = x.shape
    xf = x.astype(F32).reshape(B, n, H, 2, 2, hd // 4)
    x0, x1 = xf[..., 0, :], xf[..., 1, :]
    cs, sn = cos[:, None], sin[:, None]
    out = jnp.stack([x0 * cs - x1 * sn, x1 * cs + x0 * sn], axis=-2)
    return out.reshape(B, n, H, hd).astype(x.dtype)


def context_attention(q, k, v, sink=None):
    B, L, Hq, dh = q.shape
    Hkv = k.shape[2]
    G = Hq // Hkv
    qg = q.reshape(B, L, Hkv, G, dh)
    s = jnp.einsum('blhgd,bchd->bhglc', qg, k, preferred_element_type=F32) * dh ** -0.5
    if sink is not None:
        sk = jnp.broadcast_to(sink.astype(F32).reshape(1, Hkv, G, 1, 1), s.shape[:-1] + (1,))
        p = jax.nn.softmax(jnp.concatenate([sk, s], axis=-1), axis=-1)[..., 1:]
    else:
        p = jax.nn.softmax(s, axis=-1)
    o = jnp.einsum('bhglc,bchd->blhgd', p.astype(v.dtype), v)
    return o.reshape(B, L, Hq * dh)


def window_sink_attention(q, k, v, k_ctx, v_ctx, sink):
    B, S, Hq, dh = q.shape
    G = Hq // HKV_A
    nb = S // BLOCK
    L = k_ctx.shape[1]
    scale = dh ** -0.5
    qb = q.reshape(B, nb, BLOCK, HKV_A, G, dh)

    def band(t):
        tp = jnp.pad(t, ((0, 0), (BLOCK, BLOCK), (0, 0), (0, 0))).reshape(B, nb + 2, BLOCK, HKV_A, dh)
        return jnp.concatenate([tp[:, :-2], tp[:, 1:-1], tp[:, 2:]], axis=2)

    kb, vb = band(k), band(v)
    s_band = jnp.einsum('bnqhgd,bnkhd->bnhgqk', qb, kb, preferred_element_type=F32) * scale
    qi = jnp.arange(BLOCK)[:, None]
    kj = jnp.arange(3 * BLOCK)[None, :]
    kpos = (jnp.arange(nb) * BLOCK - BLOCK)[:, None, None] + kj
    valid = (jnp.abs(kj - BLOCK - qi) <= WINDOW) & (kpos >= 0) & (kpos < S)
    s_band = jnp.where(valid[None, :, None, None], s_band, NEG_INF)
    s_ctx = jnp.einsum('bnqhgd,bchd->bnhgqc', qb, k_ctx, preferred_element_type=F32) * scale
    sk = jnp.broadcast_to(sink.astype(F32).reshape(1, 1, HKV_A, G, 1, 1), s_ctx.shape[:-1] + (1,))
    p = jax.nn.softmax(jnp.concatenate([sk, s_ctx, s_band], axis=-1), axis=-1)
    p_ctx = p[..., 1:1 + L].astype(v.dtype)
    p_band = p[..., 1 + L:].astype(v.dtype)
    o = (jnp.einsum('bnhgqc,bchd->bnqhgd', p_ctx, v_ctx)
         + jnp.einsum('bnhgqk,bnkhd->bnqhgd', p_band, vb))
    return o.reshape(B, S, Hq * dh)


def global_block_attention(q, k, v, k_ctx, v_ctx):
    B, S, Hq, dh = q.shape
    G = Hq // HKV_C
    nb = S // BLOCK
    k_all = jnp.concatenate([k_ctx, k], axis=1)
    v_all = jnp.concatenate([v_ctx, v], axis=1)
    qb = jnp.moveaxis(q.reshape(B, nb, BLOCK, HKV_C, G, dh), 1, 0)

    def one_block(qblk):
        s = jnp.einsum('bqhgd,bkhd->bhgqk', qblk, k_all, preferred_element_type=F32) * dh ** -0.5
        p = jax.nn.softmax(s, axis=-1).astype(v_all.dtype)
        return jnp.einsum('bhgqk,bkhd->bqhgd', p, v_all)

    o = lax.map(one_block, qb)
    return jnp.moveaxis(o, 0, 1).reshape(B, S, Hq * dh)


def centred_depthwise_conv(x, w):
    ch = x.shape[-1]
    return lax.conv_general_dilated(
        x, w[:, None, :].astype(x.dtype), window_strides=(1,),
        padding=[(CONV_K // 2, CONV_K // 2)],
        dimension_numbers=('NWC', 'WIO', 'NWC'), feature_group_count=ch)


def chunk_gated_delta(q, k, v, g, beta, state0):
    B, T, H, dk = q.shape
    dv = v.shape[-1]
    n = T // CHUNK

    def chunks(t):
        return jnp.moveaxis(t.reshape((B, n, CHUNK, H) + t.shape[3:]), 3, 1)

    q, k, v, g, beta = (chunks(t) for t in (q, k, v, g, beta))
    gc = jnp.cumsum(g, axis=-1)
    lower = jnp.tril(jnp.ones((CHUNK, CHUNK), bool))
    strict = jnp.tril(jnp.ones((CHUNK, CHUNK), bool), -1)
    decay = jnp.where(lower, jnp.exp(jnp.where(lower, gc[..., :, None] - gc[..., None, :], 0.0)), 0.0)
    kb = k * beta[..., None]
    vb = v * beta[..., None]
    a_kk = jnp.where(strict, jnp.einsum('bhnid,bhnjd->bhnij', kb, k) * decay, 0.0)
    eye = jnp.eye(CHUNK, dtype=F32)
    tinv = lax.linalg.triangular_solve(a_kk + eye, jnp.broadcast_to(eye, a_kk.shape),
                                       left_side=True, lower=True, unit_diagonal=True)
    u = jnp.einsum('bhnij,bhnjd->bhnid', tinv, vb)
    w = jnp.einsum('bhnij,bhnjd->bhnid', tinv, kb * jnp.exp(gc)[..., None])
    qg = q * jnp.exp(gc)[..., None]
    a_qk = jnp.einsum('bhnid,bhnjd->bhnij', q, k) * decay
    kd = k * jnp.exp(gc[..., -1:] - gc)[..., None]
    g_end = jnp.exp(gc[..., -1])
    xs = tuple(jnp.moveaxis(t, 2, 0) for t in (qg, w, u, a_qk, kd, g_end))

    def step(s, inp):
        qg_i, w_i, u_i, a_i, kd_i, ge_i = inp
        v_new = u_i - jnp.einsum('bhcd,bhde->bhce', w_i, s)
        o = jnp.einsum('bhcd,bhde->bhce', qg_i, s) + jnp.einsum('bhij,bhje->bhie', a_i, v_new)
        s = s * ge_i[..., None, None] + jnp.einsum('bhcd,bhce->bhde', kd_i, v_new)
        return s, o

    s_final, o = lax.scan(step, state0, xs)
    o = jnp.transpose(o, (1, 0, 3, 2, 4)).reshape(B, T, H, dv)
    return o, s_final


def gated_deltanet(p_lat, p_ctx, conv_w, a_log, dt_bias, onorm):
    def prep(p):
        B, T, _ = p.shape
        qkv = jax.nn.silu(centred_depthwise_conv(p[..., :B_CONV], conv_w))
        q = l2_norm(qkv[..., :B_QK].reshape(B, T, H_B, DK_B)) * DK_B ** -0.5
        k = l2_norm(qkv[..., B_QK:2 * B_QK].reshape(B, T, H_B, DK_B))
        v = qkv[..., 2 * B_QK:].reshape(B, T, H_B, DV_B).astype(F32)
        z = p[..., B_CONV:B_CONV + B_V]
        a = p[..., B_CONV + B_V:B_CONV + B_V + 2 * H_B].astype(F32).reshape(B, T, 2, H_B)
        b = p[..., B_CONV + B_V + 2 * H_B:].astype(F32).reshape(B, T, 2, H_B)
        g = -jnp.exp(a_log.astype(F32)) * jax.nn.softplus(a + dt_bias.astype(F32))
        beta = jax.nn.sigmoid(b)
        return q, k, v, z, g, beta

    ql, kl, vl, zl, gl, bl = prep(p_lat)
    qc, kc, vc, zc, gcx, bc = prep(p_ctx)
    B = p_lat.shape[0]
    zero = jnp.zeros((B, H_B, DK_B, DV_B), F32)

    def flip(t):
        return jnp.flip(t, axis=1)

    oc_f, s_f = chunk_gated_delta(qc, kc, vc, gcx[:, :, 0], bc[:, :, 0], zero)
    ol_f, _ = chunk_gated_delta(ql, kl, vl, gl[:, :, 0], bl[:, :, 0], s_f)
    oc_b, s_b = chunk_gated_delta(flip(qc), flip(kc), flip(vc), flip(gcx[:, :, 1]), flip(bc[:, :, 1]), zero)
    ol_b, _ = chunk_gated_delta(flip(ql), flip(kl), flip(vl), flip(gl[:, :, 1]), flip(bl[:, :, 1]), s_b)

    def out_gate(o, z):
        B_, T, _ = z.shape
        y = rms_norm(o, onorm) * jax.nn.silu(z.astype(F32)).reshape(B_, T, H_B, DV_B)
        return y.reshape(B_, T, B_V).astype(z.dtype)

    return out_gate(ol_f + flip(ol_b), zl), out_gate(oc_f + flip(oc_b), zc)


def mixer_even(h_lat, h_ctx, w_in, w_out, qn, kn, sink, conv_w, a_log, dt_bias, onorm, cos, sin, with_ctx):
    B, S, _ = h_lat.shape
    L = h_ctx.shape[1]
    p_lat = h_lat @ w_in
    p_ctx = h_ctx @ w_in

    def qkv_a(p, n):
        q = rms_norm(p[..., :A_Q].reshape(B, n, HQ_A, DH_A), qn)
        k = rms_norm(p[..., A_Q:A_Q + A_KV].reshape(B, n, HKV_A, DH_A), kn)
        v = p[..., A_Q + A_KV:A_COLS].reshape(B, n, HKV_A, DH_A)
        return q, k, v

    ql, kl, vl = qkv_a(p_lat, S)
    qc, kc, vc = qkv_a(p_ctx, L)
    ql = apply_axial_rope(ql, cos, sin)
    kl = apply_axial_rope(kl, cos, sin)
    oa_lat = window_sink_attention(ql, kl, vl, kc, vc, sink)
    ob_lat, ob_ctx = gated_deltanet(p_lat[..., A_COLS:], p_ctx[..., A_COLS:], conv_w, a_log, dt_bias, onorm)
    y_lat = jnp.concatenate([oa_lat, ob_lat], axis=-1) @ w_out
    y_ctx = None
    if with_ctx:
        oa_ctx = context_attention(qc, kc, vc, sink)
        y_ctx = jnp.concatenate([oa_ctx, ob_ctx], axis=-1) @ w_out
    return y_lat, y_ctx


def mixer_odd(h_lat, h_ctx, w_in, w_out, qn, kn, cos, sin, with_ctx):
    B, S, _ = h_lat.shape
    L = h_ctx.shape[1]
    p_lat = h_lat @ w_in
    ql = apply_axial_rope(rms_norm(p_lat[..., :C_Q].reshape(B, S, HQ_C, DH_C), qn), cos, sin)
    kl = apply_axial_rope(rms_norm(p_lat[..., C_Q:C_Q + C_KV].reshape(B, S, HKV_C, DH_C), kn), cos, sin)
    vl = p_lat[..., C_Q + C_KV:].reshape(B, S, HKV_C, DH_C)
    kv_ctx = h_ctx @ w_in[:, C_Q:]
    kc = rms_norm(kv_ctx[..., :C_KV].reshape(B, L, HKV_C, DH_C), kn)
    vc = kv_ctx[..., C_KV:].reshape(B, L, HKV_C, DH_C)
    y_lat = global_block_attention(ql, kl, vl, kc, vc) @ w_out
    y_ctx = None
    if with_ctx:
        qc = rms_norm((h_ctx @ w_in[:, :C_Q]).reshape(B, L, HQ_C, DH_C), qn)
        y_ctx = context_attention(qc, kc, vc) @ w_out
    return y_lat, y_ctx


def expert_choice_moe(h, w_router, w_gate, w_up, w_down):
    B, n, D = h.shape
    cap = max(1, CAP_FACTOR * n // N_EXPERTS)
    logits = jnp.einsum('bnd,de->bne', h, w_router, preferred_element_type=F32)
    aff = jax.nn.softmax(logits, axis=-1)
    gate, idx = lax.top_k(jnp.swapaxes(aff, 1, 2), cap)
    xs = jax.vmap(lambda hb, ib: hb[ib])(h, idx)
    hid = jax.nn.silu(jnp.einsum('becd,edf->becf', xs, w_gate)) * jnp.einsum('becd,edf->becf', xs, w_up)
    ye = jnp.einsum('becf,efd->becd', hid, w_down) * gate[..., None].astype(h.dtype)
    return jax.vmap(lambda ib, yb: jnp.zeros((n, D), h.dtype).at[ib.reshape(-1)].add(yb.reshape(-1, D)))(idx, ye)


def setup_inputs(seed: int = 0) -> dict:
    key = jax.random.key(seed)
    ks = jax.random.split(key, 26)
    D = D_MODEL

    def nrm(k, shape, s):
        return jax.random.normal(k, shape, F32) * s

    def gain(k, shape):
        return 1.0 + 0.02 * jax.random.normal(k, shape, F32)

    dt = jnp.exp(jax.random.uniform(ks[15], (N_EVEN, 2, H_B), F32,
                                    float(np.log(1e-3)), float(np.log(1e-1))))
    return {
        "x": nrm(ks[0], (BATCH, SEQ, D), 1.0),
        "c": nrm(ks[1], (BATCH, D), 1.0),
        "ctx": nrm(ks[2], (BATCH, CTX_LEN, D), 1.0),
        "c_ctx": nrm(ks[3], (D,), 1.0),
        "w_mod": nrm(ks[4], (DEPTH, D, 6 * D), 0.02),
        "b_mod": nrm(ks[5], (DEPTH, 6 * D), 0.02),
        "norm_mix": gain(ks[6], (DEPTH, D)),
        "norm_ffn": gain(ks[7], (DEPTH, D)),
        "w_in_ab": nrm(ks[8], (N_EVEN, D, IN_AB), D ** -0.5),
        "w_out_ab": nrm(ks[9], (N_EVEN, OUT_AB, D), OUT_AB ** -0.5),
        "qnorm_a": gain(ks[10], (N_EVEN, DH_A)),
        "knorm_a": gain(ks[11], (N_EVEN, DH_A)),
        "sink_a": nrm(ks[12], (N_EVEN, HQ_A), 0.5),
        "conv_b": nrm(ks[13], (N_EVEN, CONV_K, B_CONV), CONV_K ** -0.5),
        "a_log_b": jnp.log(jax.random.uniform(ks[14], (N_EVEN, 2, H_B), F32, 1.0, 16.0)),
        "dt_bias_b": dt + jnp.log(-jnp.expm1(-dt)),
        "onorm_b": gain(ks[16], (N_EVEN, DV_B)),
        "w_in_c": nrm(ks[17], (N_ODD, D, IN_C), D ** -0.5),
        "w_out_c": nrm(ks[18], (N_ODD, OUT_C, D), OUT_C ** -0.5),
        "qnorm_c": gain(ks[19], (N_ODD, DH_C)),
        "knorm_c": gain(ks[20], (N_ODD, DH_C)),
        "w_router": nrm(ks[21], (DEPTH, D, N_EXPERTS), D ** -0.5),
        "w_gate": nrm(ks[22], (DEPTH, N_EXPERTS, D, EXPERT_FF), D ** -0.5),
        "w_up": nrm(ks[23], (DEPTH, N_EXPERTS, D, EXPERT_FF), D ** -0.5),
        "w_down": nrm(ks[24], (DEPTH, N_EXPERTS, EXPERT_FF, D), EXPERT_FF ** -0.5),
    }


def reference(x, c, ctx, c_ctx, w_mod, b_mod, norm_mix, norm_ffn, w_in_ab, w_out_ab, qnorm_a, knorm_a,
              sink_a, conv_b, a_log_b, dt_bias_b, onorm_b, w_in_c, w_out_c, qnorm_c, knorm_c,
              w_router, w_gate, w_up, w_down):
    rows = x.shape[1] // GRID_W
    cos_a, sin_a = axial_rope_tables(rows, DH_A)
    cos_c, sin_c = axial_rope_tables(rows, DH_C)
    xl, xc = x, ctx
    for i in range(DEPTH):
        last = i == DEPTH - 1
        j = i // 2
        m_lat = (jax.nn.silu(c) @ w_mod[i] + b_mod[i])[:, None, :]
        m_ctx = jax.nn.silu(c_ctx) @ w_mod[i] + b_mod[i]
        sh1, sc1, gt1, sh2, sc2, gt2 = jnp.split(m_lat, 6, axis=-1)
        sh1c, sc1c, gt1c, sh2c, sc2c, gt2c = jnp.split(m_ctx, 6, axis=-1)
        hl = modulate(rms_norm(xl, norm_mix[i]), sh1, sc1)
        hc = modulate(rms_norm(xc, norm_mix[i]), sh1c, sc1c)
        if i % 2 == 0:
            yl, yc = mixer_even(hl, hc, w_in_ab[j], w_out_ab[j], qnorm_a[j], knorm_a[j], sink_a[j],
                                conv_b[j], a_log_b[j], dt_bias_b[j], onorm_b[j], cos_a, sin_a, not last)
        else:
            yl, yc = mixer_odd(hl, hc, w_in_c[j], w_out_c[j], qnorm_c[j], knorm_c[j], cos_c, sin_c, not last)
        xl = xl + gt1 * yl
        hl2 = modulate(rms_norm(xl, norm_ffn[i]), sh2, sc2)
        xl = xl + gt2 * expert_choice_moe(hl2, w_router[i], w_gate[i], w_up[i], w_down[i])
        if not last:
            xc = xc + gt1c * yc
            hc2 = modulate(rms_norm(xc, norm_ffn[i]), sh2c, sc2c)
            xc = xc + gt2c * expert_choice_moe(hc2, w_router[i], w_gate[i], w_up[i], w_down[i])
    return xl
```

```cpp
#include <hip/hip_runtime.h>
#include <hip/hip_bf16.h>
#include <hip/hip_cooperative_groups.h>
#include <cstdio>
#include <cstdint>
namespace cg = cooperative_groups;
#ifndef PROBE
#define PROBE 0
#endif

constexpr int NTHREADS = 512, NWAVES = 8;
constexpr int LDS_BYTES = 147456;
constexpr int BATCH = 2, SEQ = 8192, CTXL = 256, DM = 1024;
constexpr int MLAT = BATCH * SEQ, MCTX = BATCH * CTXL, MALL = MLAT + MCTX;
constexpr int TALL = CTXL + SEQ;
constexpr int NAB = 2816, LDW_AB = 2832;
constexpr int NC = 1536;
constexpr int NEXP = 16, FF = 2048, CAPL = 1024, CAPC = 32, EROWS = 2304;
constexpr float EPS = 1e-6f;

constexpr size_t al256(size_t x) { return (x + 255) / 256 * 256; }
constexpr size_t WS_CTL   = 0;
constexpr size_t CTL_BYTES = 16384;
constexpr size_t WS_MOD   = CTL_BYTES;
constexpr size_t WS_ROPE  = al256(WS_MOD + (size_t)2 * 3 * 6144 * 4);
constexpr size_t WS_AB    = al256(WS_ROPE + (size_t)6144 * 8);
constexpr size_t WS_AFF   = al256(WS_AB + (size_t)MALL * 16 * 4);
constexpr size_t WS_IDX   = al256(WS_AFF + (size_t)2 * 16 * (SEQ + CTXL) * 4);
constexpr size_t WS_GATE  = al256(WS_IDX + (size_t)NEXP * EROWS * 4);
constexpr size_t WS_INV   = al256(WS_GATE + (size_t)NEXP * EROWS * 4);
constexpr size_t WS_WINAB = al256(WS_INV + (size_t)MALL * 16 * 4);
constexpr size_t WS_WOUTAB= al256(WS_WINAB + (size_t)NAB * DM * 2);
constexpr size_t WS_WINC  = al256(WS_WOUTAB + (size_t)DM * DM * 2);
constexpr size_t WS_WOUTC = al256(WS_WINC + (size_t)NC * DM * 2);
constexpr size_t WS_W1    = al256(WS_WOUTC + (size_t)DM * DM * 2);
constexpr size_t WS_W2    = al256(WS_W1 + (size_t)2 * NEXP * 4096 * DM * 2);
constexpr size_t WS_H     = al256(WS_W2 + (size_t)2 * NEXP * DM * FF * 2);
constexpr size_t WS_XA    = al256(WS_H + (size_t)MALL * DM * 2);
constexpr size_t WS_XB    = al256(WS_XA + (size_t)MALL * DM * 4);
constexpr size_t WS_R     = al256(WS_XB + (size_t)MALL * DM * 4);
constexpr int NCHUNK = 132;
constexpr size_t BLOB = 73984;
constexpr int BL_WN = 0, BL_QG = 16384, BL_AQK = 32768, BL_KDT = 40960, BL_U = 57344, BL_GE = 73728;
constexpr size_t WS_P     = WS_R;
constexpr size_t WS_QA    = al256(WS_P + (size_t)MALL * NAB * 2);
constexpr size_t WS_KA    = al256(WS_QA + (size_t)MLAT * DM * 2);
constexpr size_t WS_VA    = al256(WS_KA + (size_t)BATCH * TALL * 256 * 2);
constexpr size_t WS_BLOB  = al256(WS_VA + (size_t)BATCH * TALL * 256 * 2);
constexpr size_t SNAP = 49152;
constexpr size_t WS_SNAP  = al256(WS_BLOB + (size_t)16 * NCHUNK * BLOB);
constexpr size_t WS_OAB   = al256(WS_SNAP + (size_t)16 * NCHUNK * SNAP);
constexpr size_t WS_MIX_END = al256(WS_OAB + (size_t)MALL * DM * 2);
constexpr size_t WS_XG    = WS_R;
constexpr size_t WS_HID   = al256(WS_XG + (size_t)NEXP * EROWS * DM * 2);
constexpr size_t WS_YE    = al256(WS_HID + (size_t)NEXP * EROWS * FF * 2);
constexpr size_t WS_H2    = al256(WS_YE + (size_t)NEXP * EROWS * DM * 2);
constexpr size_t WS_MOE_END = al256(WS_H2 + (size_t)MALL * DM * 2);
constexpr size_t WS_END   = WS_MIX_END > WS_MOE_END ? WS_MIX_END : WS_MOE_END;
static_assert(WS_END <= (size_t)1024 * 1024 * 1024, "workspace map must fit 1 GiB");

#define LAS __attribute__((address_space(3)))
typedef unsigned short bf16_raw;
typedef unsigned u32x4_t __attribute__((ext_vector_type(4)));
typedef unsigned u32x2_t __attribute__((ext_vector_type(2)));
typedef float f32x4_t __attribute__((ext_vector_type(4)));
typedef float f32x2_t __attribute__((ext_vector_type(2)));
template <class T> __device__ __forceinline__ T* launder(T* p) { size_t z = 0; asm volatile("" : "+s"(z)); return (T*)((char*)p + z); }
__device__ __forceinline__ int opaque_tid() { int t = threadIdx.x; asm volatile("" : "+v"(t)); return t; }
__device__ __forceinline__ float bf2f(unsigned u) { return __uint_as_float(u << 16); }
__device__ __forceinline__ unsigned short f2bf_rne(float f) { unsigned u = __float_as_uint(f); return (unsigned short)((u + 0x7fffu + ((u >> 16) & 1u)) >> 16); }
__device__ __forceinline__ unsigned pk2(float lo, float hi) { return (unsigned)f2bf_rne(lo) | ((unsigned)f2bf_rne(hi) << 16); }
__device__ __forceinline__ float wave_sum(float v) {
#pragma unroll
    for (int o = 1; o < 64; o <<= 1) v += __shfl_xor(v, o);
    return v;
}
__device__ __forceinline__ float silu_f(float x) { return x / (1.f + __expf(-x)); }
__device__ __forceinline__ void unpack8(u32x4_t w, float* x) {
    x[0] = bf2f(w.x & 0xffffu); x[1] = bf2f(w.x >> 16); x[2] = bf2f(w.y & 0xffffu); x[3] = bf2f(w.y >> 16);
    x[4] = bf2f(w.z & 0xffffu); x[5] = bf2f(w.z >> 16); x[6] = bf2f(w.w & 0xffffu); x[7] = bf2f(w.w >> 16);
}
__device__ __forceinline__ u32x4_t pack8(const float* x) { u32x4_t w; w.x = pk2(x[0], x[1]); w.y = pk2(x[2], x[3]); w.z = pk2(x[4], x[5]); w.w = pk2(x[6], x[7]); return w; }

namespace pg8 {
#define PG8_LAS __attribute__((address_space(3)))
typedef unsigned short bf16_t;
typedef short bf16x8 __attribute__((ext_vector_type(8)));
typedef float f32x4 __attribute__((ext_vector_type(4)));
typedef unsigned u32x4 __attribute__((ext_vector_type(4)));
constexpr int BM = 256, BK = 64, HALF = 128, HTB = HALF * BK * 2  , STAGE_BYTES = 8 * HTB, NXCD = 8, WGM = 8;

__host__ __device__ __forceinline__ int lds_byte(int r, int c) { const int st = (r >> 4) * 2 + (c >> 5), rr = r & 15, cc = c & 31, ob = rr * 64 + cc * 2; return st * 1024 + (ob ^ (((ob >> 9) & 1) << 5)); }
__host__ __device__ __forceinline__ void stage_rc(int b, int& R, int& C) { const int st = b / 1024, sb = b % 1024, swz = sb ^ (((sb >> 9) & 1) << 5); R = (st >> 1) * 16 + swz / 64; C = (st & 1) * 32 + (swz % 64) / 2; }
__host__ __device__ __forceinline__ int perm32(int rho) { const int n = rho >> 4, i = rho & 15; return 8 * (i >> 2) + 4 * n + (i & 3); }

struct Unit { int pm, pn; };
struct Gemm { const bf16_t* A; const bf16_t* Bt; int M, N, K; const int* gidx = nullptr; };

struct StaticOrder {
    int nM, nN, nwg, G, c;
    __host__ __device__ void init(int M, int N, int G_, int c_) { nM = M / BM; nN = N / BM; nwg = nM * nN; G = G_; c = c_; }
    __host__ __device__ bool next(int i, Unit& u) const {
        const long L = (long)i * G + c; if (L >= nwg) return false;
        int wgid = (int)L; { const int q = nwg / NXCD, r = nwg % NXCD, xcd = wgid % NXCD, off = wgid / NXCD; wgid = (xcd < r ? xcd * (q + 1) : r * (q + 1) + (xcd - r) * q) + off; }
        const int nig = WGM * nN, gid = wgid / nig, fm = gid * WGM, gsz = (nM - fm) < WGM ? (nM - fm) : WGM;
        u.pm = fm + ((wgid % nig) % gsz); u.pn = (wgid % nig) / gsz; return true;
    }
    __device__ __forceinline__ void a_ready(const Unit&) const {}
    __device__ __forceinline__ void done(const Unit&) const {}
};

__device__ __forceinline__ unsigned cvt_pk_bf16(float lo, float hi) { unsigned r; asm volatile("v_cvt_pk_bf16_f32 %0, %1, %2" : "=v"(r) : "v"(lo), "v"(hi)); return r; }
typedef float f32x2 __attribute__((ext_vector_type(2)));
__device__ __forceinline__ f32x2 gelu_pk(f32x2 v) {
    const f32x2 av = __builtin_elementwise_abs(v), d = av * 0.2316418882f + 1.0f;
    f32x2 t; t.x = __builtin_amdgcn_rcpf(d.x); t.y = __builtin_amdgcn_rcpf(d.y);
    f32x2 q = t * 0.5307027145f + (-0.7265760135f); q = q * t + 0.7107068705f; q = q * t + (-0.142248368f); q = q * t + 0.127414796f; q = q * t;
    const f32x2 s = (v * v) * (-0.72134752044f);
    f32x2 e; e.x = __builtin_amdgcn_exp2f(s.x); e.y = __builtin_amdgcn_exp2f(s.y);
    const f32x2 m = v * (q * e), r = v - m;
    f32x2 o; o.x = v.x < 0.f ? m.x : r.x; o.y = v.y < 0.f ? m.y : r.y; return o;
}

template <int ACT  > struct EpiBf16 {
    static constexpr bool PERM = true, AFTER_DRAIN = false; static_assert(ACT == 0 || ACT == 1, "EpiBf16: ACT is 0 (none) or 1 (gelu_pk)");
    bf16_t* O; int ldc; const float* bias; int split_cols; size_t split_stride; float scale0;
    __device__ __forceinline__ void operator()(const f32x4 (&acc)[2][2][4][2], const Unit& u, int wr, int wc, int fr, int fq) const {
        const int row0 = u.pm * BM + wr * 64 + fr; int colt = u.pn * BM; bf16_t* base = O;
        float sc = 1.f; if (split_cols) { const int t = colt / split_cols; base += (size_t)t * split_stride; colt -= t * split_cols; if (t == 0) sc = scale0; }
        const int col0 = colt + wc * 32 + 8 * fq, bcol0 = u.pn * BM + wc * 32 + 8 * fq;
        f32x4 bv[2][2];
#pragma unroll
        for (int bj = 0; bj < 2; ++bj)
#pragma unroll
            for (int n = 0; n < 2; ++n) bv[bj][n] = bias ? *(const f32x4*)(bias + bcol0 + bj * HALF + 4 * n) : (f32x4){0.f, 0.f, 0.f, 0.f};
#pragma unroll
        for (int ai = 0; ai < 2; ++ai)
#pragma unroll
            for (int m = 0; m < 4; ++m) { bf16_t* rowp = base + (size_t)(row0 + ai * HALF + m * 16) * ldc + col0;
#pragma unroll
                for (int bj = 0; bj < 2; ++bj) { f32x4 v0 = acc[ai][bj][m][0] + bv[bj][0], v1 = acc[ai][bj][m][1] + bv[bj][1];
                    if (ACT == 1) { f32x2 a = gelu_pk((f32x2){v0[0], v0[1]}), b = gelu_pk((f32x2){v0[2], v0[3]}), c = gelu_pk((f32x2){v1[0], v1[1]}), d = gelu_pk((f32x2){v1[2], v1[3]});
                        v0 = (f32x4){a.x, a.y, b.x, b.y}; v1 = (f32x4){c.x, c.y, d.x, d.y}; }
                    v0 = v0 * sc; v1 = v1 * sc; u32x4 w; w.x = cvt_pk_bf16(v0[0], v0[1]); w.y = cvt_pk_bf16(v0[2], v0[3]); w.z = cvt_pk_bf16(v1[0], v1[1]); w.w = cvt_pk_bf16(v1[2], v1[3]);
                    *(u32x4*)(rowp + bj * HALF) = w; } }
    }
};

struct EpiResid {
    static constexpr bool PERM = false, AFTER_DRAIN = false;
    const float* res_lat; const float* res_ctx; float* out; const float* gate3;
    __device__ __forceinline__ void operator()(const f32x4 (&acc)[2][2][4][2], const Unit& u, int wr, int wc, int fr, int fq) const {
        const int rowt = u.pm * BM;
        const float* res = (rowt < MLAT) ? res_lat + (size_t)rowt * DM : res_ctx + (size_t)(rowt - MLAT) * DM;
        const int v = (rowt < MLAT) ? (rowt >> 13) : 2;
        const float* gate = gate3 + v * 6144;
        const int col0 = u.pn * BM + wc * 32 + 4 * fq;
        f32x4 gv[2][2];
#pragma unroll
        for (int bj = 0; bj < 2; ++bj)
#pragma unroll
            for (int n = 0; n < 2; ++n) gv[bj][n] = *(const f32x4*)(gate + col0 + bj * HALF + n * 16);
#pragma unroll
        for (int ai = 0; ai < 2; ++ai)
#pragma unroll
            for (int m = 0; m < 4; ++m) {
                const int row = wr * 64 + fr + ai * HALF + m * 16;
#pragma unroll
                for (int bj = 0; bj < 2; ++bj)
#pragma unroll
                    for (int n = 0; n < 2; ++n) {
                        const int c = col0 + bj * HALF + n * 16;
                        const f32x4 r4 = *(const f32x4*)(res + (size_t)row * DM + c);
                        *(f32x4*)(out + (size_t)(rowt + row) * DM + c) = r4 + gv[bj][n] * acc[ai][bj][m][n];
                    }
            }
    }
};
__device__ __forceinline__ float silu_fast(float g) { return g * __builtin_amdgcn_rcpf(1.f + __expf(-g)); }
struct EpiSwiglu {
    static constexpr bool PERM = true, AFTER_DRAIN = false;
    bf16_t* HID;
    __device__ __forceinline__ void operator()(const f32x4 (&acc)[2][2][4][2], const Unit& u, int wr, int wc, int fr, int fq) const {
        const int row0 = u.pm * BM + wr * 64 + fr, colbase = (u.pn & 15) * 128 + wc * 32 + 8 * fq;
#pragma unroll
        for (int ai = 0; ai < 2; ++ai)
#pragma unroll
            for (int m = 0; m < 4; ++m) {
                bf16_t* rowp = HID + (size_t)(row0 + ai * HALF + m * 16) * FF + colbase;
                const f32x4 g0 = acc[ai][0][m][0], g1 = acc[ai][0][m][1], u0 = acc[ai][1][m][0], u1 = acc[ai][1][m][1];
                u32x4 w;
                w.x = cvt_pk_bf16(silu_fast(g0[0]) * u0[0], silu_fast(g0[1]) * u0[1]); w.y = cvt_pk_bf16(silu_fast(g0[2]) * u0[2], silu_fast(g0[3]) * u0[3]);
                w.z = cvt_pk_bf16(silu_fast(g1[0]) * u1[0], silu_fast(g1[1]) * u1[1]); w.w = cvt_pk_bf16(silu_fast(g1[2]) * u1[2], silu_fast(g1[3]) * u1[3]);
                *(u32x4*)rowp = w;
            }
    }
};
struct EpiDown {
    static constexpr bool PERM = true, AFTER_DRAIN = false;
    bf16_t* YE; const float* gate;
    __device__ __forceinline__ void operator()(const f32x4 (&acc)[2][2][4][2], const Unit& u, int wr, int wc, int fr, int fq) const {
        const int row0 = u.pm * BM + wr * 64 + fr, colbase = (u.pn & 3) * 256 + wc * 32 + 8 * fq;
#pragma unroll
        for (int ai = 0; ai < 2; ++ai)
#pragma unroll
            for (int m = 0; m < 4; ++m) {
                const int row = row0 + ai * HALF + m * 16; const float gr = gate[row];
                bf16_t* rowp = YE + (size_t)row * DM + colbase;
#pragma unroll
                for (int bj = 0; bj < 2; ++bj) {
                    const f32x4 v0 = acc[ai][bj][m][0] * gr, v1 = acc[ai][bj][m][1] * gr;
                    u32x4 w; w.x = cvt_pk_bf16(v0[0], v0[1]); w.y = cvt_pk_bf16(v0[2], v0[3]); w.z = cvt_pk_bf16(v1[0], v1[1]); w.w = cvt_pk_bf16(v1[2], v1[3]);
                    *(u32x4*)(rowp + bj * HALF) = w;
                }
            }
    }
};
struct MoeOrder {
    int nMt, nNt, G, c, total;
    __device__ void init(int nMt_, int nNt_, int G_, int c_) { nMt = nMt_; nNt = nNt_; G = G_; c = c_; total = NEXP * nMt * nNt; }
    __device__ bool next(int i, Unit& u) const {
        if (nNt == 4 && nMt == 8 && G == 256) {
            const int x = c & 7, k = c >> 3, e = i * 8 + (x >> 1) * 2 + (k >> 4), kk = k & 15; if (e >= NEXP) return false;
            u.pm = e * 9 + (x & 1) * 4 + (kk & 3); u.pn = e * 4 + (kk >> 2); return true;
        }
        const int L = i * G + c; if (L >= total) return false;
        const int per = nMt * nNt, e = L / per, rem = L % per;
        int pnl, pml;
        if (nNt == 16) { const int j = rem & 7, t = rem >> 3; pml = t >> 1; pnl = j + 8 * (t & 1); }
        else { pnl = rem / nMt; pml = rem % nMt; }
        u.pm = e * 9 + pml; u.pn = e * nNt + pnl; return true;
    }
    __device__ __forceinline__ void a_ready(const Unit&) const {}
    __device__ __forceinline__ void done(const Unit&) const {}
};
template <class Epi, class Sched, bool ALIGN_EPI = false, bool SP2 = false, bool GATHER = false>
__device__ __forceinline__ void gemm_phase(PG8_LAS unsigned char* lds, const Gemm g, const Sched& S, const Epi& E) {
    const int tid = opaque_tid(), wid = __builtin_amdgcn_readfirstlane(tid >> 6), lane = tid & 63, wr = wid >> 2, wc = wid & 3, fr = lane & 15, fq = lane >> 4;
    const int K = g.K, nt = K / BK;
    unsigned voffA[2], voffB[2];
#pragma unroll
    for (int i = 0; i < 2; ++i) { int R, C; stage_rc(tid * 16 + i * 8192, R, C); const int Rb = Epi::PERM ? ((R & ~31) + perm32(R & 31)) : R;
        voffA[i] = (unsigned)(R * K + C) * 2u; voffB[i] = (unsigned)(Rb * K + C) * 2u; }
    static_assert(!GATHER || SP2, "GATHER is wired into the SP2 loop only");
    unsigned gcur[2][2] = {{0u, 0u}, {0u, 0u}}, gnxt[2][2] = {{0u, 0u}, {0u, 0u}};
#define PG8_GIDX(U, GO) do { _Pragma("unroll") for (int h_ = 0; h_ < 2; ++h_) _Pragma("unroll") for (int i_ = 0; i_ < 2; ++i_) { int R_, C_; stage_rc(tid * 16 + i_ * 8192, R_, C_); \
        int r_ = g.gidx[(size_t)(U).pm * BM + h_ * HALF + R_]; r_ = r_ < 0 ? 0 : r_; GO[h_][i_] = (unsigned)r_ * (unsigned)(K * 2) + (unsigned)(C_ * 2); } } while (0)
#define PG8_STAGE_G(bufoff, GO, h, kb) do { _Pragma("unroll") for (int _i = 0; _i < 2; ++_i) \
        __builtin_amdgcn_global_load_lds((const unsigned*)((const char*)g.A + (size_t)(GO)[h][_i] + (size_t)(kb)), (PG8_LAS unsigned*)(lds + (bufoff) + ldsw + _i * 8192), 16, 0, 0); } while (0)
    const size_t kstep = (size_t)(BK * 2);
    const size_t hstep = (size_t)HALF * K * 2;
    const size_t tstep = 2 * hstep;
    const unsigned ldsw = (unsigned)wid * 1024u;
    const int aoff = lds_byte(wr * 64 + fr, fq * 8), boff = lds_byte(wc * 32 + fr, fq * 8);
#define PG8_SA(b, h) (((b) * 2 + (h)) * HTB)
#define PG8_SB(b, h) ((4 + (b) * 2 + (h)) * HTB)
#define PG8_STAGE(bufoff, gbase, voff) do { _Pragma("unroll") for (int _i = 0; _i < 2; ++_i) \
        __builtin_amdgcn_global_load_lds((const unsigned*)((const char*)(gbase) + (voff)[_i]), (PG8_LAS unsigned*)(lds + (bufoff) + ldsw + _i * 8192), 16, 0, 0); } while (0)
#define PG8_LDA(dst, b, h) do { _Pragma("unroll") for (int m = 0; m < 4; ++m) _Pragma("unroll") for (int k = 0; k < 2; ++k) dst[m][k] = *(const PG8_LAS bf16x8*)(lds + PG8_SA(b, h) + aoff + m * 2048 + k * 1024); } while (0)
#define PG8_LDB(dst, b, h) do { _Pragma("unroll") for (int n = 0; n < 2; ++n) _Pragma("unroll") for (int k = 0; k < 2; ++k) dst[n][k] = *(const PG8_LAS bf16x8*)(lds + PG8_SB(b, h) + boff + n * 2048 + k * 1024); } while (0)
#define PG8_MMA(ai, bj, At, Bt) do { __builtin_amdgcn_s_setprio(1); _Pragma("unroll") for (int m = 0; m < 4; ++m) _Pragma("unroll") for (int n = 0; n < 2; ++n) _Pragma("unroll") for (int k = 0; k < 2; ++k) \
        acc[ai][bj][m][n] = __builtin_amdgcn_mfma_f32_16x16x32_bf16(Bt[n][k], At[m][k], acc[ai][bj][m][n], 0, 0, 0); __builtin_amdgcn_s_setprio(0); } while (0)
#define PG8_WAIT_V(n) asm volatile("s_waitcnt vmcnt(" #n ")" ::: "memory")
#define PG8_WAIT_L(n) asm volatile("s_waitcnt lgkmcnt(" #n ")" ::: "memory")
#define PG8_BAR __builtin_amdgcn_s_barrier()
#define PG8_SCHED __builtin_amdgcn_sched_barrier(0)
    Unit cur, nxt; int ui = 0;
    if (!S.next(0, cur)) return;
    f32x4 acc[2][2][4][2];
#pragma unroll
    for (int a = 0; a < 2; ++a)
#pragma unroll
        for (int b = 0; b < 2; ++b)
#pragma unroll
            for (int m = 0; m < 4; ++m)
#pragma unroll
                for (int n = 0; n < 2; ++n) acc[a][b][m][n] = (f32x4){0.f, 0.f, 0.f, 0.f};
    bf16x8 At[4][2], B0[2][2], B1[2][2];
    const char* cA = (const char*)g.A + (size_t)cur.pm * tstep; const char* cB = (const char*)g.Bt + (size_t)cur.pn * tstep;
    S.a_ready(cur);
    if constexpr (GATHER) PG8_GIDX(cur, gcur);
    if constexpr (SP2) {
        PG8_STAGE(PG8_SB(0, 0), cB, voffB); PG8_STAGE(PG8_SB(0, 1), cB + hstep, voffB);
        if constexpr (GATHER) { PG8_STAGE_G(PG8_SA(0, 0), gcur, 0, 0); PG8_STAGE_G(PG8_SA(0, 1), gcur, 1, 0); } else { PG8_STAGE(PG8_SA(0, 0), cA, voffA); PG8_STAGE(PG8_SA(0, 1), cA + hstep, voffA); }
        if (wr == 1) PG8_BAR;
        PG8_WAIT_V(2); PG8_BAR;
        PG8_STAGE(PG8_SB(1, 0), cB + kstep, voffB); if constexpr (GATHER) PG8_STAGE_G(PG8_SA(1, 0), gcur, 0, kstep); else PG8_STAGE(PG8_SA(1, 0), cA + kstep, voffA); PG8_STAGE(PG8_SB(1, 1), cB + hstep + kstep, voffB);
        PG8_WAIT_V(6); PG8_BAR;
    } else {
        PG8_STAGE(PG8_SB(0, 0), cB, voffB); PG8_STAGE(PG8_SA(0, 0), cA, voffA); PG8_STAGE(PG8_SB(0, 1), cB + hstep, voffB); PG8_STAGE(PG8_SA(0, 1), cA + hstep, voffA);
        if (wr == 1) PG8_BAR;
        PG8_WAIT_V(4); PG8_BAR;
        PG8_STAGE(PG8_SB(1, 0), cB + kstep, voffB); PG8_STAGE(PG8_SA(1, 0), cA + kstep, voffA); PG8_STAGE(PG8_SB(1, 1), cB + hstep + kstep, voffB);
        PG8_WAIT_V(6); PG8_BAR;
    }
    for (;;) {
        const bool has_next = S.next(ui + 1, nxt);
        if constexpr (GATHER) { if (has_next) PG8_GIDX(nxt, gnxt); }
        const char* nA = has_next ? (const char*)g.A + (size_t)nxt.pm * tstep : cA; const char* nB = has_next ? (const char*)g.Bt + (size_t)nxt.pn * tstep : cB;
        for (int t = 0; t < nt; t += 2) {
            const bool last = (t == nt - 2);
            const char* a1 = cA + (size_t)(t + 1) * kstep;
            const char* a2 = last ? nA : cA + (size_t)(t + 2) * kstep; const char* b2 = last ? nB : cB + (size_t)(t + 2) * kstep;
            const char* a3 = a2 + kstep; const char* b3 = b2 + kstep;
            if (last && has_next) S.a_ready(nxt);
            unsigned g2[2][2]; size_t k1 = 0, k2 = 0;
            if constexpr (GATHER) {
                const bool usen = last && has_next;
#pragma unroll
                for (int h_ = 0; h_ < 2; ++h_)
#pragma unroll
                    for (int i_ = 0; i_ < 2; ++i_) g2[h_][i_] = usen ? gnxt[h_][i_] : gcur[h_][i_];
                k1 = (size_t)(t + 1) * kstep; k2 = last ? 0 : (size_t)(t + 2) * kstep;
            }
            if constexpr (SP2) {
            PG8_LDB(B0, 0, 0); PG8_LDB(B1, 0, 1); PG8_SCHED; PG8_LDA(At, 0, 0); if constexpr (GATHER) PG8_STAGE_G(PG8_SA(1, 1), gcur, 1, k1); else PG8_STAGE(PG8_SA(1, 1), a1 + hstep, voffA);
            PG8_WAIT_V(8); PG8_WAIT_L(0); PG8_BAR; PG8_MMA(0, 0, At, B0); PG8_MMA(0, 1, At, B1); PG8_BAR; PG8_SCHED;
            PG8_LDA(At, 0, 1); PG8_STAGE(PG8_SB(0, 0), b2, voffB); PG8_STAGE(PG8_SB(0, 1), b2 + hstep, voffB); if constexpr (GATHER) PG8_STAGE_G(PG8_SA(0, 0), g2, 0, k2); else PG8_STAGE(PG8_SA(0, 0), a2, voffA);
            PG8_WAIT_V(8); PG8_WAIT_L(0); PG8_BAR; PG8_MMA(1, 0, At, B0); PG8_MMA(1, 1, At, B1); PG8_BAR; PG8_SCHED;
            PG8_LDB(B0, 1, 0); PG8_LDB(B1, 1, 1); PG8_SCHED; PG8_LDA(At, 1, 0); if constexpr (GATHER) PG8_STAGE_G(PG8_SA(0, 1), g2, 1, k2); else PG8_STAGE(PG8_SA(0, 1), a2 + hstep, voffA);
            PG8_WAIT_V(8); PG8_WAIT_L(0); PG8_BAR; PG8_MMA(0, 0, At, B0); PG8_MMA(0, 1, At, B1); PG8_BAR; PG8_SCHED;
            PG8_LDA(At, 1, 1); PG8_STAGE(PG8_SB(1, 0), b3, voffB); PG8_STAGE(PG8_SB(1, 1), b3 + hstep, voffB); if constexpr (GATHER) PG8_STAGE_G(PG8_SA(1, 0), g2, 0, k2 + kstep); else PG8_STAGE(PG8_SA(1, 0), a3, voffA);
            PG8_WAIT_V(8); PG8_WAIT_L(0); PG8_BAR; PG8_MMA(1, 0, At, B0); PG8_MMA(1, 1, At, B1); PG8_BAR; PG8_SCHED;
            } else {
            PG8_LDB(B0, 0, 0); PG8_SCHED; PG8_LDA(At, 0, 0); PG8_STAGE(PG8_SA(1, 1), a1 + hstep, voffA);
            PG8_WAIT_L(8); PG8_BAR; PG8_WAIT_L(0); PG8_MMA(0, 0, At, B0); PG8_BAR; PG8_SCHED;
            PG8_LDB(B1, 0, 1); PG8_STAGE(PG8_SB(0, 0), b2, voffB);
            PG8_BAR; PG8_WAIT_L(0); PG8_MMA(0, 1, At, B1); PG8_BAR;
            PG8_LDA(At, 0, 1); PG8_STAGE(PG8_SA(0, 0), a2, voffA);
            PG8_BAR; PG8_WAIT_L(0); PG8_MMA(1, 0, At, B0); PG8_BAR; PG8_SCHED;
            PG8_STAGE(PG8_SB(0, 1), b2 + hstep, voffB);
            PG8_WAIT_V(6); PG8_BAR; PG8_MMA(1, 1, At, B1); PG8_BAR;
            PG8_LDB(B0, 1, 0); PG8_SCHED; PG8_LDA(At, 1, 0); PG8_STAGE(PG8_SA(0, 1), a2 + hstep, voffA);
            PG8_WAIT_L(8); PG8_BAR; PG8_WAIT_L(0); PG8_MMA(0, 0, At, B0); PG8_BAR; PG8_SCHED;
            PG8_LDB(B1, 1, 1); PG8_STAGE(PG8_SB(1, 0), b3, voffB);
            PG8_BAR; PG8_WAIT_L(0); PG8_MMA(0, 1, At, B1); PG8_BAR;
            PG8_LDA(At, 1, 1); PG8_STAGE(PG8_SA(1, 0), a3, voffA);
            PG8_BAR; PG8_WAIT_L(0); PG8_MMA(1, 0, At, B0); PG8_BAR; PG8_SCHED;
            PG8_STAGE(PG8_SB(1, 1), b3 + hstep, voffB);
            PG8_WAIT_V(6); PG8_BAR; PG8_MMA(1, 1, At, B1); PG8_BAR;
            }
        }
        if constexpr (ALIGN_EPI) { if (wr == 0) PG8_BAR; }
        if constexpr (!Epi::AFTER_DRAIN) { E(acc, cur, wr, wc, fr, fq); S.done(cur); }
        if (!has_next) break;
#pragma unroll
        for (int a = 0; a < 2; ++a)
#pragma unroll
            for (int b = 0; b < 2; ++b)
#pragma unroll
                for (int m = 0; m < 4; ++m)
#pragma unroll
                    for (int n = 0; n < 2; ++n) acc[a][b][m][n] = (f32x4){0.f, 0.f, 0.f, 0.f};
        cur = nxt; cA = nA; cB = nB; ++ui;
        if constexpr (GATHER) { _Pragma("unroll") for (int h_ = 0; h_ < 2; ++h_) _Pragma("unroll") for (int i_ = 0; i_ < 2; ++i_) gcur[h_][i_] = gnxt[h_][i_]; }
        if constexpr (ALIGN_EPI) { if (wr == 1) PG8_BAR; }
    }
    PG8_WAIT_V(0);
    if constexpr (!ALIGN_EPI) { if (wr == 0) PG8_BAR; }
    PG8_BAR;
    if constexpr (Epi::AFTER_DRAIN) { E.fused(acc, cur, wr, wc, fr, fq, lds, wid, lane); S.done(cur); }
#undef PG8_SA
#undef PG8_SB
#undef PG8_STAGE
#undef PG8_STAGE_G
#undef PG8_GIDX
#undef PG8_LDA
#undef PG8_LDB
#undef PG8_MMA
#undef PG8_WAIT_V
#undef PG8_WAIT_L
#undef PG8_BAR
#undef PG8_SCHED
}
}

namespace attc {
using bf16 = __hip_bfloat16;
constexpr int   D = 128, NW = 8, QBLK = 32, KVBLK = 64;
constexpr float SCALE = 0.088388347648318440f;
constexpr float THR = 8.f;
constexpr int LAYOUT = 1, SDEPTH = 1;
constexpr int HQ = 8, HKV = 2;
constexpr int LDQ = HQ * D, LDK = HKV * D, LDO = LDQ;
constexpr size_t SHM_V = KVBLK * D * 2, SHM_K = KVBLK * D * 2, SHM_ATTN = 2 * SHM_V + 2 * SHM_K + NW * 64 * 4;
using bf16x8 = __attribute__((ext_vector_type(8))) short;
using s16x4  = __attribute__((ext_vector_type(4))) short;
using f32x16 = __attribute__((ext_vector_type(16))) float;
using f32x8  = __attribute__((ext_vector_type(8))) float;
using u32x4  = __attribute__((ext_vector_type(4))) unsigned;
#define KSWZ(row, colB) ((row) * 256 + ((colB) ^ (((row) & 7) << 4)))
#define SBAR() __builtin_amdgcn_sched_barrier(0)
__device__ __forceinline__ int crow(int r, int hi) { return (r & 3) + 8 * (r >> 2) + 4 * hi; }
__device__ __forceinline__ unsigned cvtpk(float lo, float hi) {
  unsigned r; asm volatile("v_cvt_pk_bf16_f32 %0, %1, %2" : "=v"(r) : "v"(lo), "v"(hi)); return r;
}
template <typename TIn> struct Stage;
template <> struct Stage<bf16>  { using T = bf16x8;
  __device__ static __forceinline__ T ld8(const bf16* p) { return *reinterpret_cast<const bf16x8*>(p); }
  __device__ static __forceinline__ bf16x8 tobf(T x) { return x; } };
template <> struct Stage<float> { using T = f32x8;
  __device__ static __forceinline__ T ld8(const float* p) { return *reinterpret_cast<const f32x8*>(p); }
  __device__ static __forceinline__ bf16x8 tobf(T x) {
    u32x4 w = {cvtpk(x[0], x[1]), cvtpk(x[2], x[3]), cvtpk(x[4], x[5]), cvtpk(x[6], x[7])}; return *reinterpret_cast<bf16x8*>(&w); } };

__device__ __forceinline__ void partialSM(f32x16& p0, f32x16& p1, float& m_reg, float& mn, float& alpha) {
  constexpr float C = SCALE * 1.4426950408889634f;
  float pmax = p0[0]; for (int r = 1; r < 16; ++r) pmax = fmaxf(pmax, p0[r]); for (int r = 0; r < 16; ++r) pmax = fmaxf(pmax, p1[r]);
  { auto rr = __builtin_amdgcn_permlane32_swap(__float_as_uint(pmax), __float_as_uint(pmax), false, false);
    pmax = fmaxf(__uint_as_float(rr[0]), __uint_as_float(rr[1])); }
  if (__builtin_expect(__all(pmax - m_reg <= THR / SCALE), 1)) { mn = m_reg; alpha = 1.f; }
  else { mn = fmaxf(m_reg, pmax); alpha = __builtin_amdgcn_exp2f((m_reg - mn) * C); m_reg = mn; }
  float mnC = -mn * C;
  for (int r = 0; r < 16; ++r) p0[r] = fmaf(p0[r], C, mnC); for (int r = 0; r < 16; ++r) p1[r] = fmaf(p1[r], C, mnC);
  for (int r = 0; r < 16; ++r) p0[r] = __builtin_amdgcn_exp2f(p0[r]);
}
__device__ __forceinline__ void finishSM(f32x16& p0, f32x16& p1, float alpha, float& l_reg, bf16x8& pa0, bf16x8& pa1, bf16x8& pa2, bf16x8& pa3) {
  for (int r = 0; r < 16; ++r) p1[r] = __builtin_amdgcn_exp2f(p1[r]);
  float ps = 0; for (int r = 0; r < 16; ++r) ps += p0[r]; for (int r = 0; r < 16; ++r) ps += p1[r];
  { auto rr = __builtin_amdgcn_permlane32_swap(__float_as_uint(ps), __float_as_uint(ps), false, false);
    ps = __uint_as_float(rr[0]) + __uint_as_float(rr[1]); }
  l_reg = l_reg * alpha + ps;
#define PK4(P, BASE, OUT) do { unsigned a0 = cvtpk(P[BASE + 0], P[BASE + 1]), a1 = cvtpk(P[BASE + 2], P[BASE + 3]);   \
    unsigned b0 = cvtpk(P[BASE + 4], P[BASE + 5]), b1 = cvtpk(P[BASE + 6], P[BASE + 7]);                              \
    auto r0 = __builtin_amdgcn_permlane32_swap(a0, b0, false, false); auto r1 = __builtin_amdgcn_permlane32_swap(a1, b1, false, false); \
    u32x4 w = {r0[0], r1[0], r0[1], r1[1]}; OUT = *reinterpret_cast<bf16x8*>(&w); } while (0)
  PK4(p0, 0, pa0); PK4(p0, 8, pa1); PK4(p1, 0, pa2); PK4(p1, 8, pa3);
#undef PK4
}
__device__ __forceinline__ void qkt(f32x16& p0, f32x16& p1, const bf16* Ks, const bf16x8* qr, int r32, int hi) {
  p0 = f32x16{}; p1 = f32x16{};
  for (int d0 = 0; d0 < 8; ++d0) { int cb = (d0 * 16 + hi * 8) * 2;
    bf16x8 b0 = *reinterpret_cast<const bf16x8*>((const char*)Ks + KSWZ(r32, cb));
    bf16x8 b1 = *reinterpret_cast<const bf16x8*>((const char*)Ks + KSWZ(32 + r32, cb));
    p0 = __builtin_amdgcn_mfma_f32_32x32x16_bf16(b0, qr[d0], p0, 0, 0, 0);
    p1 = __builtin_amdgcn_mfma_f32_32x32x16_bf16(b1, qr[d0], p1, 0, 0, 0); }
}
__device__ __forceinline__ int v_st(int k, int c) { const int kk = (k & ~0xC) | ((k & 4) << 1) | ((k & 8) >> 1); return ((kk >> 3) * 4 + (c >> 5)) * 512 + ((kk & 7) * 32 + (c & 31)) * 2; }
__device__ __forceinline__ int v_rd_base(int lane) { return ((lane & 3) << 3) | (((lane >> 2) & 3) << 6) | (((lane >> 4) & 1) << 5) | (((lane >> 5) & 1) << 8); }
constexpr int v_rd_off(int d0, int ks, int half) { return d0 * 512 + ks * 4096 + half * 2048; }
template <int OFF> __device__ __forceinline__ s16x4 tr_read(int vb) {
  s16x4 r; asm volatile("ds_read_b64_tr_b16 %0, %1 offset:%2" : "=&v"(r) : "v"(vb), "i"(OFF) : "memory"); return r;
}
template <int D0> __device__ __forceinline__ void pv_one(f32x16& od, int vb, bf16x8 pa0, bf16x8 pa1, bf16x8 pa2, bf16x8 pa3) {
  const s16x4 l0 = tr_read<v_rd_off(D0, 0, 0)>(vb), h0 = tr_read<v_rd_off(D0, 0, 1)>(vb), l1 = tr_read<v_rd_off(D0, 1, 0)>(vb), h1 = tr_read<v_rd_off(D0, 1, 1)>(vb);
  const s16x4 l2 = tr_read<v_rd_off(D0, 2, 0)>(vb), h2 = tr_read<v_rd_off(D0, 2, 1)>(vb), l3 = tr_read<v_rd_off(D0, 3, 0)>(vb), h3 = tr_read<v_rd_off(D0, 3, 1)>(vb);
  asm volatile("s_waitcnt lgkmcnt(0)" ::: "memory"); SBAR();
#define PK(L, H) (bf16x8){L[0], L[1], L[2], L[3], H[0], H[1], H[2], H[3]}
  od = __builtin_amdgcn_mfma_f32_32x32x16_bf16(pa0, PK(l0, h0), od, 0, 0, 0);
  od = __builtin_amdgcn_mfma_f32_32x32x16_bf16(pa1, PK(l1, h1), od, 0, 0, 0);
  od = __builtin_amdgcn_mfma_f32_32x32x16_bf16(pa2, PK(l2, h2), od, 0, 0, 0);
  od = __builtin_amdgcn_mfma_f32_32x32x16_bf16(pa3, PK(l3, h3), od, 0, 0, 0);
#undef PK
}
__device__ __forceinline__ void pv_d0(f32x16* o, int vb, bf16x8 pa0, bf16x8 pa1, bf16x8 pa2, bf16x8 pa3) {
  pv_one<0>(o[0], vb, pa0, pa1, pa2, pa3); pv_one<1>(o[1], vb, pa0, pa1, pa2, pa3); pv_one<2>(o[2], vb, pa0, pa1, pa2, pa3); pv_one<3>(o[3], vb, pa0, pa1, pa2, pa3);
}

template <typename TQ>
__device__ __forceinline__ void attn_dense_body(const TQ* Qb, const bf16* Kh, const bf16* Vh,
                                                bf16_raw* Ob, int seq, char* lds) {
  using St = Stage<bf16>; using SQ = Stage<TQ>;
  const int tid = opaque_tid(), wid = tid >> 6, lane = tid & 63, r32 = lane & 31, hi = lane >> 5;
  bf16* V_lds = (bf16*)lds; bf16* K_lds = (bf16*)(lds + 2 * SHM_V);
  float* ws = (float*)(lds + 2 * SHM_V + 2 * SHM_K) + wid * 64; float* li_l = ws; float* al_l = ws + 32;
  float m_reg = -1e30f, l_reg = 0; f32x16 o[4] = {}; bf16x8 qr[8];
  const TQ* Qw = Qb + (long)(wid * QBLK + r32) * LDQ + hi * 8;
#pragma unroll
  for (int d0 = 0; d0 < 8; ++d0) qr[d0] = SQ::tobf(SQ::ld8(Qw + d0 * 16));
  const int sr = tid >> 4, sc = (tid & 15) * 8, vst0 = v_st(sr, sc), vst1 = v_st(32 + sr, sc);
  const int vb0 = (int)(uintptr_t)V_lds + v_rd_base(lane);
  struct { typename St::T vs0, vs1, ks0, ks1; } sr_[SDEPTH];
#define SLOAD(i, k0) do { sr_[i].vs0 = St::ld8(&Vh[(long)((k0) + sr) * LDK + sc]); sr_[i].vs1 = St::ld8(&Vh[(long)((k0) + 32 + sr) * LDK + sc]); \
    sr_[i].ks0 = St::ld8(&Kh[(long)((k0) + sr) * LDK + sc]); sr_[i].ks1 = St::ld8(&Kh[(long)((k0) + 32 + sr) * LDK + sc]); } while (0)
#define SWRITE(b, i) do { *(bf16x8*)((char*)V_lds + (b) * SHM_V + vst0) = St::tobf(sr_[i].vs0);          \
    *(bf16x8*)((char*)V_lds + (b) * SHM_V + vst1) = St::tobf(sr_[i].vs1); int kc = sc * 2;               \
    *(bf16x8*)((char*)K_lds + (b) * SHM_K + KSWZ(sr, kc)) = St::tobf(sr_[i].ks0);                       \
    *(bf16x8*)((char*)K_lds + (b) * SHM_K + KSWZ(32 + sr, kc)) = St::tobf(sr_[i].ks1); } while (0)
#define SWAIT() do { if constexpr (SDEPTH == 2) asm volatile("s_waitcnt vmcnt(4)" ::: "memory"); else asm volatile("s_waitcnt vmcnt(0)" ::: "memory"); } while (0)
#define RESC(a) do { if (__any((a) < 1.f)) { if (hi == 0) al_l[r32] = (a); asm volatile("s_waitcnt lgkmcnt(0)" ::: "memory"); \
    for (int d = 0; d < 4; ++d) for (int r = 0; r < 16; ++r) o[d][r] *= al_l[crow(r, hi)]; } } while (0)
  f32x16 pA0, pA1, pB0, pB1; float mnA, mnB, alA, alB; bf16x8 pa0, pa1, pa2, pa3; const int NT = seq / KVBLK;
  constexpr int SE = 0, SO = SDEPTH - 1;
  SLOAD(SE, 0); asm volatile("s_waitcnt vmcnt(0)" ::: "memory"); SWRITE(0, SE); __syncthreads();
  qkt(pA0, pA1, K_lds, qr, r32, hi); partialSM(pA0, pA1, m_reg, mnA, alA);
  SLOAD(SO, KVBLK); if constexpr (SDEPTH == 2) { if (2 < NT) SLOAD(SE, 2 * KVBLK); }
  SWAIT(); SWRITE(1, SO); __syncthreads();
  for (int j = 1; j + 1 < NT; j += 2) {
    SBAR(); qkt(pB0, pB1, (bf16*)((char*)K_lds + SHM_K), qr, r32, hi);
    finishSM(pA0, pA1, alA, l_reg, pa0, pa1, pa2, pa3); SBAR();
    SLOAD(SO, (j + SDEPTH) * KVBLK); SBAR();
    pv_d0(o, vb0, pa0, pa1, pa2, pa3); partialSM(pB0, pB1, m_reg, mnB, alB);
    __syncthreads(); SWAIT(); SWRITE(0, SE);
    RESC(alB); __syncthreads();
    SBAR(); qkt(pA0, pA1, K_lds, qr, r32, hi);
    finishSM(pB0, pB1, alB, l_reg, pa0, pa1, pa2, pa3); SBAR();
    if (SDEPTH == 1 || j + 3 < NT) SLOAD(SE, (j + 1 + SDEPTH) * KVBLK); SBAR();
    pv_d0(o, vb0 + (int)SHM_V, pa0, pa1, pa2, pa3); partialSM(pA0, pA1, m_reg, mnA, alA);
    __syncthreads(); SWAIT(); SWRITE(1, SO);
    RESC(alA); __syncthreads();
  }
  SBAR(); qkt(pB0, pB1, (bf16*)((char*)K_lds + SHM_K), qr, r32, hi);
  finishSM(pA0, pA1, alA, l_reg, pa0, pa1, pa2, pa3); SBAR();
  pv_d0(o, vb0, pa0, pa1, pa2, pa3); partialSM(pB0, pB1, m_reg, mnB, alB);
  __syncthreads(); RESC(alB);
  finishSM(pB0, pB1, alB, l_reg, pa0, pa1, pa2, pa3); SBAR();
  pv_d0(o, vb0 + (int)SHM_V, pa0, pa1, pa2, pa3);
  if (hi == 0) li_l[r32] = l_reg; asm volatile("s_waitcnt lgkmcnt(0)" ::: "memory");
  float rli[16];
#pragma unroll
  for (int r = 0; r < 16; ++r) rli[r] = __builtin_amdgcn_rcpf(li_l[crow(r, hi)]);
  bf16_raw* Ow = Ob + (long)(wid * QBLK) * LDO;
#pragma unroll
  for (int r = 0; r < 16; ++r) { int orow = crow(r, hi);
    for (int d0 = 0; d0 < 4; ++d0) Ow[(long)orow * LDO + d0 * 32 + r32] = f2bf_rne(o[d0][r] * rli[r]); }
#undef SLOAD
#undef SWRITE
#undef SWAIT
#undef RESC
}
}
#define XB_TMO      128
#define XB_XCNT(j)  (256  + 64 * (j))
#define XB_XSUB(j)  (1280 + 64 * (j))
#define XB_XGEN(j)  (2304 + 64 * (j))
#define XB_TOP      3328
#define XB_TOPGEN   3392
#define XCD_BAR_WORDS 3456
#define XB_SPIN_CAP (1u << 18)

__device__ __forceinline__ unsigned xb_ld(unsigned* p)              { return __hip_atomic_load(p, __ATOMIC_RELAXED, __HIP_MEMORY_SCOPE_AGENT); }
__device__ __forceinline__ unsigned xb_add(unsigned* p, unsigned v) { return __hip_atomic_fetch_add(p, v, __ATOMIC_RELAXED, __HIP_MEMORY_SCOPE_AGENT); }
__device__ __forceinline__ unsigned xb_xcc_id() { return (unsigned)__builtin_amdgcn_s_getreg((3 << 11) | 20) & 0xFu; }
#define XB_SPIN(cond, bar) do { unsigned _sp = 0; while (cond) { __builtin_amdgcn_s_sleep(1); \
    if ((++_sp & 255u) == 0u) { if (xb_ld(&(bar)[XB_TMO])) break; if (_sp > XB_SPIN_CAP) { atomicAdd(&(bar)[XB_TMO], 1u); break; } } } } while (0)

struct XcdBarrier {
    unsigned* bar; unsigned x;
    volatile LAS unsigned* st;
};

__device__ __forceinline__ XcdBarrier xcd_barrier_post(unsigned* bar, volatile LAS unsigned* st) {
    XcdBarrier b; b.bar = bar; b.x = xb_xcc_id(); b.st = st;
    if (threadIdx.x == 0) (void)xb_add(&bar[XB_XCNT(b.x)], 1u);
    return b;
}
__device__ __forceinline__ void xcd_barrier_complete(unsigned* bar, unsigned x, unsigned& nloc, unsigned& nx) {
    const unsigned G = gridDim.x * gridDim.y * gridDim.z;
    unsigned sum, cnt, mine, sp = 0u;
    for (;;) {
        sum = 0u; cnt = 0u; mine = 0u;
#pragma unroll
        for (unsigned j = 0; j < 16; ++j) { const unsigned c = xb_ld(&bar[XB_XCNT(j)]); sum += c; cnt += (c > 0u) ? 1u : 0u; mine = (j == x) ? c : mine; }
        if (sum == G) break;
        __builtin_amdgcn_s_sleep(1);
        if ((++sp & 255u) == 0u) { if (xb_ld(&bar[XB_TMO])) break; if (sp > XB_SPIN_CAP) { atomicAdd(&bar[XB_TMO], 1u); break; } }
    }
    nloc = mine > 0u ? mine : 1u; nx = cnt > 0u ? cnt : 1u;
}

__device__ __forceinline__ void xcd_barrier(const XcdBarrier& b) {
    asm volatile("s_waitcnt vmcnt(0)" ::: "memory");
    __syncthreads();
    if (threadIdx.x == 0) {
        unsigned* bar = b.bar;
        __builtin_amdgcn_s_waitcnt(0);
        unsigned nloc = b.st[0], nx = b.st[1];
        if (nloc == 0u) { xcd_barrier_complete(bar, b.x, nloc, nx); b.st[0] = nloc; b.st[1] = nx; }
        const unsigned old = xb_add(&bar[XB_XSUB(b.x)], 1u);
        const unsigned gen = old / nloc;
        if (old + 1u == (gen + 1u) * nloc) {
            __builtin_amdgcn_fence(__ATOMIC_RELEASE, "agent");
            asm volatile("s_waitcnt vmcnt(0)" ::: "memory");
            const unsigned og = xb_add(&bar[XB_TOP], 1u);
            const unsigned tg = og / nx;
            if (og + 1u == (tg + 1u) * nx) xb_add(&bar[XB_TOPGEN], 1u);
            else XB_SPIN(xb_ld(&bar[XB_TOPGEN]) == tg, bar);
            __builtin_amdgcn_fence(__ATOMIC_ACQUIRE, "agent");
            xb_add(&bar[XB_XGEN(b.x)], 1u);
            asm volatile("s_waitcnt vmcnt(0)" ::: "memory");
        } else {
            XB_SPIN(xb_ld(&bar[XB_XGEN(b.x)]) == gen, bar);
            __builtin_amdgcn_fence(__ATOMIC_ACQUIRE, "agent");
            asm volatile("s_waitcnt vmcnt(0)" ::: "memory");
        }
    }
    __syncthreads();
}


struct Params { const float* in[25]; float* out; unsigned char* ws; };
enum { I_X = 0, I_C, I_CTX, I_CCTX, I_WMOD, I_BMOD, I_NMIX, I_NFFN, I_WINAB, I_WOUTAB, I_QNA, I_KNA, I_SINK, I_CONV, I_ALOG, I_DTB, I_ONORM,
       I_WINC, I_WOUTC, I_QNC, I_KNC, I_WR, I_WG, I_WU, I_WD };

constexpr int TRI_AB = 16 * 11, TRI_OAB = 16 * 4, TRI_CC = 16 * 6, TRI_OC = 16 * 4, TRI_W1 = 16 * 16, TRI_W2 = 32 * 4;
constexpr int TRI_SMALL = TRI_AB + TRI_OAB + TRI_CC + TRI_OC;
constexpr int TR_SET_A = TRI_SMALL + 16 * TRI_W1 + 16 * TRI_W2, TR_SET_B = 16 * TRI_W1 + 16 * TRI_W2;
__device__ __forceinline__ void tr_items(const Params& p, LAS unsigned char* lds, int set, int first, int stride, int count) {
    const int tid = opaque_tid();
    unsigned char* ws = launder(p.ws);
    const int setsize = set ? TR_SET_B : TR_SET_A;
    LAS float* tile = (LAS float*)lds;
    const int lrow = tid >> 6, col4 = (tid & 63) * 4;
    f32x4_t v[8];
    const float* src0 = nullptr; const float* src1 = nullptr; int ld = 0; bf16_raw* dstp = nullptr; int dK = 0;
#define TR_ITEM(j) (set == 0 ? ((j) < TRI_SMALL + 16 * TRI_W1 ? (j) : (j) + 16 * TRI_W1) : ((j) < 16 * TRI_W1 ? (j) + TRI_SMALL + 16 * TRI_W1 : (j) + TRI_SMALL + 16 * TRI_W1 + 16 * TRI_W2))
#define TR_DECODE(item) do { int r = (item); \
        if (r < TRI_AB) { const int kb = r / 11, nb = r % 11; ld = LDW_AB; src0 = p.in[I_WINAB] + (size_t)(64 * kb) * ld + 256 * nb; src1 = src0 + 128; dK = 1024; dstp = (bf16_raw*)(ws + WS_WINAB) + (size_t)(256 * nb) * 1024 + 64 * kb; break; } r -= TRI_AB; \
        if (r < TRI_OAB) { const int kb = r / 4, nb = r % 4; ld = 1024; src0 = p.in[I_WOUTAB] + (size_t)(64 * kb) * ld + 256 * nb; src1 = src0 + 128; dK = 1024; dstp = (bf16_raw*)(ws + WS_WOUTAB) + (size_t)(256 * nb) * 1024 + 64 * kb; break; } r -= TRI_OAB; \
        if (r < TRI_CC) { const int kb = r / 6, nb = r % 6; ld = NC; src0 = p.in[I_WINC] + (size_t)(64 * kb) * ld + 256 * nb; src1 = src0 + 128; dK = 1024; dstp = (bf16_raw*)(ws + WS_WINC) + (size_t)(256 * nb) * 1024 + 64 * kb; break; } r -= TRI_CC; \
        if (r < TRI_OC) { const int kb = r / 4, nb = r % 4; ld = 1024; src0 = p.in[I_WOUTC] + (size_t)(64 * kb) * ld + 256 * nb; src1 = src0 + 128; dK = 1024; dstp = (bf16_raw*)(ws + WS_WOUTC) + (size_t)(256 * nb) * 1024 + 64 * kb; break; } r -= TRI_OC; \
        if (r < 32 * TRI_W1) { const int le = r / TRI_W1, q = r % TRI_W1, kb = q / 16, pn = q % 16; ld = 2048; \
            src0 = p.in[I_WG] + (size_t)le * 1024 * 2048 + (size_t)(64 * kb) * ld + 128 * pn; src1 = p.in[I_WU] + (size_t)le * 1024 * 2048 + (size_t)(64 * kb) * ld + 128 * pn; \
            dK = 1024; dstp = (bf16_raw*)(ws + WS_W1) + (size_t)le * 4096 * 1024 + (size_t)(256 * pn) * 1024 + 64 * kb; break; } r -= 32 * TRI_W1; \
        { const int le = r / TRI_W2, q = r % TRI_W2, kb = q / 4, nb = q % 4; ld = 1024; src0 = p.in[I_WD] + (size_t)le * 2048 * 1024 + (size_t)(64 * kb) * ld + 256 * nb; src1 = src0 + 128; \
          dK = 2048; dstp = (bf16_raw*)(ws + WS_W2) + (size_t)le * 1024 * 2048 + (size_t)(256 * nb) * 2048 + 64 * kb; } } while (0)
#define TR_LOAD() do { const float* s_ = (col4 < 128 ? src0 + col4 : src1 + (col4 - 128)); _Pragma("unroll") for (int i = 0; i < 8; ++i) v[i] = *(const f32x4_t*)(s_ + (size_t)(lrow + 8 * i) * ld); } while (0)
    int j = first, k = 0;
    if (k < count && j < setsize) { TR_DECODE(TR_ITEM(j)); TR_LOAD(); }
    for (; k < count && j < setsize; ++k, j += stride) {
        bf16_raw* dcur = dstp; const int kcur = dK;
        __syncthreads();
#pragma unroll
        for (int i = 0; i < 8; ++i) { const int row = lrow + 8 * i; *(LAS f32x4_t*)(tile + row * 260 + 4 * ((col4 >> 2) ^ ((row >> 3) & 7))) = v[i]; }
        if (k + 1 < count && j + stride < setsize) { TR_DECODE(TR_ITEM(j + stride)); TR_LOAD(); }
        __syncthreads();
#pragma unroll
        for (int j4 = 0; j4 < 4; ++j4) {
            const int id = tid + 512 * j4, c = id & 7, n = id >> 3;
            const LAS float* s_ = tile + (8 * c) * 260 + 4 * ((n >> 2) ^ c) + (n & 3);
            u32x4_t o; o.x = pk2(s_[0], s_[260]); o.y = pk2(s_[2 * 260], s_[3 * 260]); o.z = pk2(s_[4 * 260], s_[5 * 260]); o.w = pk2(s_[6 * 260], s_[7 * 260]);
            *(u32x4_t*)(dcur + (size_t)n * kcur + 8 * c) = o;
        }
    }
    __syncthreads();
#undef TR_ITEM
#undef TR_DECODE
#undef TR_LOAD
}
__device__ __forceinline__ void phase_prep_weights(const Params& p, LAS unsigned char* lds, int bg_end) {
    const int tid = opaque_tid(), lane = tid & 63, wave = tid >> 6, G = gridDim.x, bid = blockIdx.x;
    unsigned char* ws = launder(p.ws);
    for (int modrep = 0; modrep < (PROBE == 20 ? 2 : 1); ++modrep)
    if (bid < 192) {
        const int l = bid / 96, j = (bid % 96) * 64 + lane;
        const float* wm = p.in[I_WMOD] + (size_t)l * 1024 * 6144 + j;
        LAS float* sc = (LAS float*)lds;
        for (int i = tid; i < 3072; i += NTHREADS) { const float x = (i < 2048) ? p.in[I_C][i] : p.in[I_CCTX][i - 2048]; sc[i] = silu_f(x); }
        __syncthreads();
        float a0 = 0.f, a1 = 0.f, a2 = 0.f;
        for (int k0 = 0; k0 < 1024; k0 += 128) {
            float wv[16];
#pragma unroll
            for (int i = 0; i < 16; ++i) wv[i] = wm[(size_t)(k0 + wave + 8 * i) * 6144];
#pragma unroll
            for (int i = 0; i < 16; ++i) { const int k = k0 + wave + 8 * i; a0 += sc[k] * wv[i]; a1 += sc[1024 + k] * wv[i]; a2 += sc[2048 + k] * wv[i]; }
        }
        __syncthreads();
        LAS float* red = (LAS float*)(lds + 131072);
        red[(wave * 3 + 0) * 64 + lane] = a0; red[(wave * 3 + 1) * 64 + lane] = a1; red[(wave * 3 + 2) * 64 + lane] = a2;
        __syncthreads();
        if (wave < 3) {
            float s = 0.f;
#pragma unroll
            for (int w = 0; w < 8; ++w) s += red[(w * 3 + wave) * 64 + lane];
            float* MOD = (float*)(ws + WS_MOD);
            MOD[(size_t)(l * 3 + wave) * 6144 + j] = s + p.in[I_BMOD][l * 6144 + j];
        }
        __syncthreads();
    }
    if (bid >= 192 && bid < 204) {
        const int g = (bid - 192) * NTHREADS + tid;
        if (g < 6144) {
            const int q = g < 2048 ? 16 : 32, gg = g < 2048 ? g : g - 2048, pos = gg / q, i = gg % q;
            const float inv = powf(10000.f, -(float)i / (float)q), ang = (float)pos * inv;
            float sn, cs; sincosf(ang, &sn, &cs);
            ((f32x2_t*)(ws + WS_ROPE))[g] = (f32x2_t){cs, sn};
        }
    }
    if (bg_end == -1) return;
    tr_items(p, lds, 0, bid, G, (TR_SET_A + G - 1) / G);
    if (bg_end < TR_SET_B) tr_items(p, lds, 1, bg_end + bid, G, (TR_SET_B - bg_end + G - 1) / G);
}

template <int MODE>
__device__ __forceinline__ void norm_dots(const f32x4_t (&h)[4], LAS float* wt, int lane, float (&a)[16]) {
#pragma unroll
    for (int e = 0; e < 16; ++e) {
        float s = 0.f;
#pragma unroll
        for (int j = 0; j < 4; ++j) { const f32x4_t w4 = *(const LAS f32x4_t*)(wt + e * 1024 + 4 * lane + 256 * j); s += h[j].x * w4.x + h[j].y * w4.y + h[j].z * w4.z + h[j].w * w4.w; }
        a[e] = s;
        if ((e & 3) == 3) __builtin_amdgcn_sched_barrier(0);
    }
#pragma unroll
    for (int e = 0; e < 16; ++e) a[e] = wave_sum(a[e]);
}
__device__ __forceinline__ void norm_apply(f32x4_t (&v)[4], const float* gain, const float* modp, int lane) {
    float ss = 0.f;
#pragma unroll
    for (int j = 0; j < 4; ++j) ss += v[j].x * v[j].x + v[j].y * v[j].y + v[j].z * v[j].z + v[j].w * v[j].w;
    const float rms = rsqrtf(wave_sum(ss) * (1.f / 1024.f) + EPS);
#pragma unroll
    for (int j = 0; j < 4; ++j) {
        const int k = 4 * lane + 256 * j;
        const f32x4_t g = *(const f32x4_t*)(gain + k), sh = *(const f32x4_t*)(modp + k), sc = *(const f32x4_t*)(modp + 1024 + k);
        v[j] = (v[j] * rms * g) * (sc + 1.f) + sh;
    }
}
__device__ __forceinline__ void store_h(const f32x4_t (&v)[4], bf16_raw* hrow, int lane) {
#pragma unroll
    for (int j = 0; j < 4; ++j) { u32x2_t w; w.x = pk2(v[j].x, v[j].y); w.y = pk2(v[j].z, v[j].w); *(u32x2_t*)(hrow + 4 * lane + 256 * j) = w; }
}
template <int MODE>
__device__ __forceinline__ void row_aux(const f32x4_t (&v)[4], LAS float* wt, int lane, int r, float* aux) {
    if (MODE == 0) return;
    float a[16]; norm_dots<MODE>(v, wt, lane, a);
    if (MODE == 2) {
        float mx = a[0];
#pragma unroll
        for (int e = 1; e < 16; ++e) mx = fmaxf(mx, a[e]);
        float sum = 0.f;
#pragma unroll
        for (int e = 0; e < 16; ++e) { a[e] = expf(a[e] - mx); sum += a[e]; }
        const float inv = 1.f / sum;
#pragma unroll
        for (int e = 0; e < 16; ++e) a[e] *= inv;
    }
    float val = 0.f;
#pragma unroll
    for (int e = 0; e < 16; ++e) if (lane == e) val = a[e];
    if (lane < 16) {
        if (MODE == 1) aux[(size_t)r * 16 + lane] = val;
        else { if (r < MLAT) aux[(size_t)((r >> 13) * 16 + lane) * SEQ + (r & (SEQ - 1))] = val;
               else { const int rc = r - MLAT; aux[(size_t)2 * 16 * SEQ + (size_t)((rc >> 8) * 16 + lane) * CTXL + (rc & 255)] = val; } }
    }
}
__device__ __forceinline__ void stage_w16(const float* W16, int ldw, LAS float* wt) {
    const int tid = opaque_tid();
    f32x4_t v[8];
#pragma unroll
    for (int i = 0; i < 8; ++i) { const int id = tid + NTHREADS * i, k = id >> 2, e4 = id & 3; v[i] = *(const f32x4_t*)(W16 + (size_t)k * ldw + 4 * e4); }
#pragma unroll
    for (int i = 0; i < 8; ++i) { const int id = tid + NTHREADS * i, k = id >> 2, e4 = id & 3;
        wt[(4 * e4 + 0) * 1024 + k] = v[i].x; wt[(4 * e4 + 1) * 1024 + k] = v[i].y; wt[(4 * e4 + 2) * 1024 + k] = v[i].z; wt[(4 * e4 + 3) * 1024 + k] = v[i].w; }
    __syncthreads();
}
template <int MODE>
__device__ __forceinline__ void norm_dots2(const f32x4_t (&h0)[4], const f32x4_t (&h1)[4], LAS float* wt, int lane, float (&a0)[16], float (&a1)[16]) {
    LAS float* wtl = wt + 4 * lane;
#pragma unroll
    for (int e = 0; e < 16; ++e) {
        float s0 = 0.f, s1 = 0.f;
#pragma unroll
        for (int j = 0; j < 4; ++j) { const f32x4_t w4 = *(const LAS f32x4_t*)(wtl + e * 1024 + 256 * j);
            s0 += h0[j].x * w4.x + h0[j].y * w4.y + h0[j].z * w4.z + h0[j].w * w4.w; s1 += h1[j].x * w4.x + h1[j].y * w4.y + h1[j].z * w4.z + h1[j].w * w4.w; }
        a0[e] = s0; a1[e] = s1;
        if ((e & 3) == 3) __builtin_amdgcn_sched_barrier(0);
    }
#pragma unroll
    for (int e = 0; e < 16; ++e) { a0[e] = wave_sum(a0[e]); a1[e] = wave_sum(a1[e]); }
}
template <int MODE>
__device__ __forceinline__ void aux_store(float (&a)[16], int lane, int r, float* aux) {
    if (MODE == 2) {
        float mx = a[0];
#pragma unroll
        for (int e = 1; e < 16; ++e) mx = fmaxf(mx, a[e]);
        float sum = 0.f;
#pragma unroll
        for (int e = 0; e < 16; ++e) { a[e] = expf(a[e] - mx); sum += a[e]; }
        const float inv = 1.f / sum;
#pragma unroll
        for (int e = 0; e < 16; ++e) a[e] *= inv;
    }
    float val = 0.f;
#pragma unroll
    for (int e = 0; e < 16; ++e) if (lane == e) val = a[e];
    if (lane < 16) {
        if (MODE == 1) aux[(size_t)r * 16 + lane] = val;
        else { if (r < MLAT) aux[(size_t)((r >> 13) * 16 + lane) * SEQ + (r & (SEQ - 1))] = val;
               else { const int rc = r - MLAT; aux[(size_t)2 * 16 * SEQ + (size_t)((rc >> 8) * 16 + lane) * CTXL + (rc & 255)] = val; } }
    }
}
__device__ __forceinline__ void norm_apply2(f32x4_t (&v)[4], const f32x4_t (&gm)[4], const f32x4_t (&sh)[4]) {
    float ss = 0.f;
#pragma unroll
    for (int j = 0; j < 4; ++j) ss += v[j].x * v[j].x + v[j].y * v[j].y + v[j].z * v[j].z + v[j].w * v[j].w;
    const float rms = rsqrtf(wave_sum(ss) * (1.f / 1024.f) + EPS);
#pragma unroll
    for (int j = 0; j < 4; ++j) v[j] = (v[j] * rms) * gm[j] + sh[j];
}
__device__ __forceinline__ void norm_modvec(const float* gain, const float* modp, int lane, f32x4_t (&gm)[4], f32x4_t (&sh)[4]) {
#pragma unroll
    for (int j = 0; j < 4; ++j) { const int k = 4 * lane + 256 * j; const f32x4_t g = *(const f32x4_t*)(gain + k), sc = *(const f32x4_t*)(modp + 1024 + k); sh[j] = *(const f32x4_t*)(modp + k); gm[j] = g * (sc + 1.f); }
}
template <int MODE>
__device__ __forceinline__ void phase_norm(const float* src_lat, const float* src_ctx, int nrows, const float* gain, const float* mod3, bf16_raw* Hout,
                                           const float* W16, int ldw, float* aux, LAS unsigned char* lds) {
    const int tid = opaque_tid(), lane = tid & 63, wave = tid >> 6;
    LAS float* wt = (LAS float*)lds;
    if (MODE != 0) stage_w16(W16, ldw, wt);
    const int gw = blockIdx.x * NWAVES + wave;
#define NORM_LOAD(V, src_) do { _Pragma("unroll") for (int j = 0; j < 4; ++j) V[j] = *(const f32x4_t*)((src_) + 4 * lane + 256 * j); } while (0)
#define NORM_PAIR(V0, V1, R0) do { \
        norm_apply2(V0, gm, sh); norm_apply2(V1, gm, sh); \
        store_h(V0, Hout + (size_t)(R0) * DM, lane); store_h(V1, Hout + (size_t)((R0) + 1) * DM, lane); \
        if (MODE != 0) { float a0[16], a1[16]; norm_dots2<MODE>(V0, V1, wt, lane, a0, a1); aux_store<MODE>(a0, lane, (R0), aux); aux_store<MODE>(a1, lane, (R0) + 1, aux); } } while (0)
    {
        const int r0 = gw * 8;
        f32x4_t gm[4], sh[4]; norm_modvec(gain, mod3 + (r0 >> 13) * 6144, lane, gm, sh);
        const float* src = src_lat + (size_t)r0 * DM;
        f32x4_t n0[4], n1[4];
        NORM_LOAD(n0, src); NORM_LOAD(n1, src + DM);
#pragma unroll 1
        for (int i = 0; i < 6; i += 2) {
            f32x4_t v0[4], v1[4];
#pragma unroll
            for (int j = 0; j < 4; ++j) { v0[j] = n0[j]; v1[j] = n1[j]; }
            NORM_LOAD(n0, src + (size_t)(i + 2) * DM); NORM_LOAD(n1, src + (size_t)(i + 3) * DM);
            NORM_PAIR(v0, v1, r0 + i);
        }
        NORM_PAIR(n0, n1, r0 + 6);
    }
    if (nrows > MLAT && gw < nrows - MLAT) {
        const int r = MLAT + gw;
        f32x4_t gm[4], sh[4]; norm_modvec(gain, mod3 + 2 * 6144, lane, gm, sh);
        f32x4_t v[4]; NORM_LOAD(v, src_ctx + (size_t)gw * DM);
        norm_apply2(v, gm, sh);
        store_h(v, Hout + (size_t)r * DM, lane);
        row_aux<MODE>(v, wt, lane, r, aux);
    }
#undef NORM_PAIR
#undef NORM_LOAD
}

template <int NE, int QUARTER>
__device__ __forceinline__ void rope_cs(const f32x2_t* tab, int hl0, int t, float* cs, float* sn) {
    const int i0 = hl0 & (QUARTER - 1), axis = (hl0 / (2 * QUARTER)) & 1;
    const int pos = axis ? (t & 63) : (t >> 6);
    const f32x4_t* tp = (const f32x4_t*)(tab + pos * QUARTER + i0);
#pragma unroll
    for (int e = 0; e < NE / 2; ++e) { const f32x4_t w = tp[e]; cs[2 * e] = w.x; sn[2 * e] = w.y; cs[2 * e + 1] = w.z; sn[2 * e + 1] = w.w; }
}
template <int NE, int QUARTER>
__device__ __forceinline__ void rope_apply(float* y, int hl0, const float* cs, const float* sn) {
    const bool first = ((hl0 / QUARTER) & 1) == 0;
#pragma unroll
    for (int e = 0; e < NE; ++e) { const float yp = __shfl_xor(y[e], 2); y[e] = first ? (y[e] * cs[e] - yp * sn[e]) : (y[e] * cs[e] + yp * sn[e]); }
}

__device__ __forceinline__ void phase_prep0(const Params& p, int wg_rank, int n_wgs) {
    const int tid = opaque_tid(), lane = tid & 63, wave = tid >> 6;
    unsigned char* ws = launder(p.ws);
    const bf16_raw* P = (const bf16_raw*)(ws + WS_P);
    bf16_raw* QA = (bf16_raw*)(ws + WS_QA); bf16_raw* KA = (bf16_raw*)(ws + WS_KA); bf16_raw* VA = (bf16_raw*)(ws + WS_VA);
    const f32x2_t* tab = (const f32x2_t*)(ws + WS_ROPE);
    const int gw = wg_rank * NWAVES + wave, NGW = n_wgs * NWAVES;
    const int hl0 = 8 * (lane & 7);
    float qn[8], kn[8];
#pragma unroll
    for (int e = 0; e < 8; ++e) { qn[e] = p.in[I_QNA][hl0 + e]; kn[e] = p.in[I_KNA][hl0 + e]; }
    u32x4_t wq, wk, wqn = {0u, 0u, 0u, 0u}, wkn = {0u, 0u, 0u, 0u};
    int r = gw;
    if (r < MALL) { const bf16_raw* prow = P + (size_t)r * NAB; wq = *(const u32x4_t*)(prow + 8 * lane); wk = *(const u32x4_t*)(prow + 512 + 8 * (lane & 31)); }
    for (; r < MALL; r += NGW) {
        const int rn = r + NGW;
        if (rn < MALL) { const bf16_raw* prow = P + (size_t)rn * NAB; wqn = *(const u32x4_t*)(prow + 8 * lane); wkn = *(const u32x4_t*)(prow + 512 + 8 * (lane & 31)); }
        const bool isctx = r >= MLAT; const int rc = isctx ? r - MLAT : r;
        const int b = isctx ? (rc >> 8) : (rc >> 13), t = isctx ? (rc & 255) : (rc & 8191);
        float cs[8], sn[8];
        if (!isctx) rope_cs<8, 16>(tab, hl0, t, cs, sn);
        {
            float x[8]; unpack8(wq, x);
            float ss = 0.f;
#pragma unroll
            for (int e = 0; e < 8; ++e) ss += x[e] * x[e];
            ss += __shfl_xor(ss, 1); ss += __shfl_xor(ss, 2); ss += __shfl_xor(ss, 4);
            const float rms = rsqrtf(ss * (1.f / 64.f) + EPS);
#pragma unroll
            for (int e = 0; e < 8; ++e) x[e] = x[e] * rms * qn[e];
            if (!isctx) rope_apply<8, 16>(x, hl0, cs, sn);
            *(u32x4_t*)(QA + (size_t)r * 512 + 8 * lane) = pack8(x);
        }
        {
            float x[8]; unpack8(wk, x);
            float ss = 0.f;
#pragma unroll
            for (int e = 0; e < 8; ++e) ss += x[e] * x[e];
            ss += __shfl_xor(ss, 1); ss += __shfl_xor(ss, 2); ss += __shfl_xor(ss, 4);
            const float rms = rsqrtf(ss * (1.f / 64.f) + EPS);
#pragma unroll
            for (int e = 0; e < 8; ++e) x[e] = x[e] * rms * kn[e];
            if (!isctx) rope_apply<8, 16>(x, hl0, cs, sn);
            const size_t dst = ((size_t)b * TALL + (isctx ? t : CTXL + t)) * 128;
            if (lane < 16) *(u32x4_t*)(KA + dst + 8 * lane) = pack8(x);
            else if (lane < 32) *(u32x4_t*)(VA + dst + 8 * (lane - 16)) = wk;
        }
        wq = wqn; wk = wkn;
    }
}

typedef short bf16x8_t __attribute__((ext_vector_type(8)));
typedef float f32x16_t __attribute__((ext_vector_type(16)));
__device__ __forceinline__ int crow16(int r, int hi) { return (r & 3) + 8 * (r >> 2) + 4 * hi; }
typedef float cvt_f32x2_t __attribute__((ext_vector_type(2)));
typedef __bf16 cvt_bf16x2_t __attribute__((ext_vector_type(2)));
__device__ __forceinline__ unsigned cvtpk_a(float lo, float hi) { const cvt_f32x2_t v = {lo, hi}; const cvt_bf16x2_t b = __builtin_convertvector(v, cvt_bf16x2_t); return __builtin_bit_cast(unsigned, b); }
__device__ __forceinline__ void attnA_unit(const Params& p, LAS unsigned char* lds, int b, int kvh, int qrow0  , int q0, bool latent) {
    constexpr float SCALE = 0.125f, C = SCALE * 1.4426950408889634f;
    constexpr int PITCH = 144;
    const int tid = opaque_tid(), lane = tid & 63, wave = tid >> 6, r32 = lane & 31, hi = lane >> 5;
    unsigned char* ws = launder(p.ws);
    const bf16_raw* QA = (const bf16_raw*)(ws + WS_QA); const bf16_raw* KA = (const bf16_raw*)(ws + WS_KA); const bf16_raw* VA = (const bf16_raw*)(ws + WS_VA);
    bf16_raw* OAB = (bf16_raw*)(ws + WS_OAB);
    LAS unsigned char* Ks = lds; LAS unsigned char* Vt = lds + 64 * PITCH; LAS float* wsc = (LAS float*)(lds + 2 * 64 * PITCH) + wave * 64;
    const int h = kvh * 4 + (wave >> 1), rowoff = 32 * (wave & 1);
    bf16x8_t qr[4];
    const bf16_raw* qrow = QA + (size_t)(qrow0 + rowoff + r32) * 512 + h * 64 + hi * 8;
#pragma unroll
    for (int d0 = 0; d0 < 4; ++d0) qr[d0] = *(const bf16x8_t*)(qrow + d0 * 16);
    float m_reg = p.in[I_SINK][h] * 8.f, l_reg = 1.f;
    f32x16_t o[2];
#pragma unroll
    for (int d = 0; d < 2; ++d)
#pragma unroll
        for (int r = 0; r < 16; ++r) o[d][r] = 0.f;
    const int q0w = q0 + rowoff;
    const int ntiles = latent ? 9 : 4;
    const size_t kvbase = (size_t)b * TALL;
    const int skey = tid >> 3, schunk = tid & 7;
#define TILE_KI0(tj) ((tj) < 4 ? 64 * (tj) : CTXL + q0 - 128 + 64 * ((tj) - 4))
#define TILE_OK(tj) ((tj) < 4 || (q0 - 128 + 64 * ((tj) - 4) >= 0 && q0 - 128 + 64 * ((tj) - 4) < SEQ))
    u32x4_t kw = {0u, 0u, 0u, 0u}, vw = {0u, 0u, 0u, 0u};
    { const size_t g = (kvbase + skey) * 128 + kvh * 64 + 8 * schunk; kw = *(const u32x4_t*)(KA + g); vw = *(const u32x4_t*)(VA + g); }
    for (int tj = 0; tj < ntiles; ++tj) {
        if (!TILE_OK(tj)) continue;
        __syncthreads();
        {
            *(LAS u32x4_t*)(Ks + skey * PITCH + schunk * 16) = kw;
            u32x4_t vo; vo.x = __shfl_down(vw.x, 8); vo.y = __shfl_down(vw.y, 8); vo.z = __shfl_down(vw.z, 8); vo.w = __shfl_down(vw.w, 8);
            if ((skey & 1) == 0) {
                const int kp = skey >> 1;
                LAS unsigned* vt = (LAS unsigned*)Vt + (8 * schunk) * 36 + 4 * ((kp >> 2) ^ schunk) + (kp & 3);
                vt[0 * 36] = (vw.x & 0xffffu) | (vo.x << 16); vt[1 * 36] = (vw.x >> 16) | (vo.x & 0xffff0000u);
                vt[2 * 36] = (vw.y & 0xffffu) | (vo.y << 16); vt[3 * 36] = (vw.y >> 16) | (vo.y & 0xffff0000u);
                vt[4 * 36] = (vw.z & 0xffffu) | (vo.z << 16); vt[5 * 36] = (vw.z >> 16) | (vo.z & 0xffff0000u);
                vt[6 * 36] = (vw.w & 0xffffu) | (vo.w << 16); vt[7 * 36] = (vw.w >> 16) | (vo.w & 0xffff0000u);
            }
        }
        {
            int tn = tj + 1; while (tn < ntiles && !TILE_OK(tn)) ++tn;
            if (tn < ntiles) { const size_t g = (kvbase + TILE_KI0(tn) + skey) * 128 + kvh * 64 + 8 * schunk; kw = *(const u32x4_t*)(KA + g); vw = *(const u32x4_t*)(VA + g); }
        }
        __syncthreads();
        f32x16_t p0, p1;
#pragma unroll
        for (int r = 0; r < 16; ++r) { p0[r] = 0.f; p1[r] = 0.f; }
#pragma unroll
        for (int d0 = 0; d0 < 4; ++d0) {
            const int cb = (16 * d0 + 8 * hi) * 2;
            const bf16x8_t k0 = *(const LAS bf16x8_t*)(Ks + r32 * PITCH + cb), k1 = *(const LAS bf16x8_t*)(Ks + (32 + r32) * PITCH + cb);
            p0 = __builtin_amdgcn_mfma_f32_32x32x16_bf16(k0, qr[d0], p0, 0, 0, 0);
            p1 = __builtin_amdgcn_mfma_f32_32x32x16_bf16(k1, qr[d0], p1, 0, 0, 0);
        }
        if (tj >= 4 && tj != 6) {
            const int kpos0 = q0 - 128 + 64 * (tj - 4), qpos = q0w + r32;
#pragma unroll
            for (int r = 0; r < 16; ++r) {
                const int d0 = kpos0 + crow16(r, hi) - qpos, d1 = d0 + 32;
                if (d0 > 128 || d0 < -128) p0[r] = -1e30f;
                if (d1 > 128 || d1 < -128) p1[r] = -1e30f;
            }
        }
        float pmax = p0[0];
#pragma unroll
        for (int r = 1; r < 16; ++r) pmax = fmaxf(pmax, p0[r]);
#pragma unroll
        for (int r = 0; r < 16; ++r) pmax = fmaxf(pmax, p1[r]);
        pmax = fmaxf(pmax, __shfl_xor(pmax, 32));
        const float mn = fmaxf(m_reg, pmax);
        const float alpha = __builtin_amdgcn_exp2f((m_reg - mn) * C);
        m_reg = mn;
        const float mnC = -mn * C;
        float ps = 0.f;
#pragma unroll
        for (int r = 0; r < 16; ++r) { p0[r] = __builtin_amdgcn_exp2f(fmaf(p0[r], C, mnC)); p1[r] = __builtin_amdgcn_exp2f(fmaf(p1[r], C, mnC)); ps += p0[r] + p1[r]; }
        ps += __shfl_xor(ps, 32);
        l_reg = l_reg * alpha + ps;
        if (hi == 0) wsc[r32] = alpha;
        asm volatile("s_waitcnt lgkmcnt(0)" ::: "memory");
#pragma unroll
        for (int r = 0; r < 16; ++r) { const float al = wsc[crow16(r, hi)]; o[0][r] *= al; o[1][r] *= al; }
        bf16x8_t pa[4];
#define PK4A(P, BASE, OUT) do { unsigned a0 = cvtpk_a(P[BASE + 0], P[BASE + 1]), a1 = cvtpk_a(P[BASE + 2], P[BASE + 3]);   \
    unsigned b0 = cvtpk_a(P[BASE + 4], P[BASE + 5]), b1 = cvtpk_a(P[BASE + 6], P[BASE + 7]);                              \
    auto r0 = __builtin_amdgcn_permlane32_swap(a0, b0, false, false); auto r1 = __builtin_amdgcn_permlane32_swap(a1, b1, false, false); \
    u32x4_t w_ = {r0[0], r1[0], r0[1], r1[1]}; OUT = *reinterpret_cast<bf16x8_t*>(&w_); } while (0)
        PK4A(p0, 0, pa[0]); PK4A(p0, 8, pa[1]); PK4A(p1, 0, pa[2]); PK4A(p1, 8, pa[3]);
#undef PK4A
#pragma unroll
        for (int d = 0; d < 2; ++d) {
            const int dd = 32 * d + r32;
#pragma unroll
            for (int ks = 0; ks < 4; ++ks) {
                const bf16x8_t vf = *(const LAS bf16x8_t*)(Vt + dd * PITCH + 16 * ((2 * ks + hi) ^ ((dd >> 3) & 7)));
                o[d] = __builtin_amdgcn_mfma_f32_32x32x16_bf16(pa[ks], vf, o[d], 0, 0, 0);
            }
        }
    }
#undef TILE_KI0
#undef TILE_OK
    if (hi == 0) wsc[r32] = l_reg;
    asm volatile("s_waitcnt lgkmcnt(0)" ::: "memory");
#pragma unroll
    for (int r = 0; r < 16; ++r) {
        const int orow = crow16(r, hi); const float rl = 1.f / wsc[orow];
        bf16_raw* op = OAB + (size_t)(qrow0 + rowoff + orow) * DM + h * 64 + r32;
        op[0] = f2bf_rne(o[0][r] * rl); op[32] = f2bf_rne(o[1][r] * rl);
    }
}

__device__ __forceinline__ int pos32(int a) { return 8 * ((a & 15) >> 2) + 4 * (a >> 4) + (a & 3); }
__device__ __forceinline__ int act32(int pos) { const int q = pos >> 3, j = pos & 7; return j < 4 ? 4 * q + j : 16 + 4 * q + (j - 4); }
typedef short bf16x8_s __attribute__((ext_vector_type(8)));
typedef float f32x4_s __attribute__((ext_vector_type(4)));
__device__ __forceinline__ unsigned cvtpk_b(float lo, float hi) { return cvtpk_a(lo, hi); }
template <int VAR>
__device__ __forceinline__ void bprep_unit(const Params& p, LAS unsigned char* lds, int unit) {
    const int tid = opaque_tid(), lane = tid & 63, wave = tid >> 6;
    unsigned char* ws = launder(p.ws);
    const int b = unit / (4 * NCHUNK), h = (unit / NCHUNK) & 3, c = unit % NCHUNK;
    const bool isctx = c < 4;
    const int t0 = isctx ? 64 * c : 64 * (c - 4), tlen = isctx ? CTXL : SEQ;
    const int row0 = isctx ? MLAT + b * CTXL + t0 : b * SEQ + t0;
    constexpr int TP = 272;
    LAS unsigned char* KT = lds; LAS unsigned char* VT = lds + 17408;
    LAS float* AM = (LAS float*)(lds + 34816);
    LAS float* SC = (LAS float*)(lds + 67584);
    LAS unsigned char* QT = lds + 69632; LAS float* Gm = (LAS float*)(lds + 69632 + 17408); LAS float* QKm = (LAS float*)(lds + 69632 + 2 * 17408);
    LAS bf16_raw* XT = (LAS bf16_raw*)(lds + 69632);
    unsigned char* blob0 = ws + (VAR ? WS_H : WS_BLOB) + (size_t)((b * 4 + h) * 2 * NCHUNK + c) * BLOB;
    __syncthreads();
    if (wave < 2) {
        const int d = wave, ti = d ? 63 - lane : lane, row = row0 + ti;
        const float* AB = (const float*)(ws + WS_AB);
        const float a = AB[(size_t)row * 16 + d * 4 + h], bb = AB[(size_t)row * 16 + 8 + d * 4 + h];
        const float xx = a + p.in[I_DTB][d * 4 + h];
        const float sp = fmaxf(xx, 0.f) + log1pf(expf(-fabsf(xx)));
        float gc = -expf(p.in[I_ALOG][d * 4 + h]) * sp;
#pragma unroll
        for (int o = 1; o < 64; o <<= 1) { const float y = __shfl_up(gc, o); if (lane >= o) gc += y; }
        SC[d * 64 + lane] = gc; SC[128 + d * 64 + lane] = 1.f / (1.f + expf(-bb)); SC[256 + d * 64 + lane] = expf(gc);
    }
    LAS float* cwl = (LAS float*)(lds + 136192);
    for (int i = tid; i < 5 * 384; i += NTHREADS) { const int j = i / 384, rr = i % 384, pp = rr >> 7, ch = rr & 127; cwl[i] = p.in[I_CONV][j * 1536 + pp * 512 + h * 128 + ch]; }
    LAS unsigned char* inp[3] = {lds + 34816, lds + 87040, lds + 105536};
    if (VAR != 4) {
        const bf16_raw* P = (const bf16_raw*)(ws + WS_P);
        u32x4_t st[7];
#pragma unroll
        for (int it = 0; it < 7; ++it) {
            const int i = tid + NTHREADS * it; st[it] = (u32x4_t){0u, 0u, 0u, 0u};
            if (i < 3264) { const int part = i / 1088, rem = i % 1088, row = rem >> 4, ch = rem & 15, tt = t0 - 2 + row;
                if (tt >= 0 && tt < tlen) st[it] = *(const u32x4_t*)(P + (size_t)(row0 - 2 + row) * NAB + 768 + part * 512 + h * 128 + ch * 8); }
        }
#pragma unroll
        for (int it = 0; it < 7; ++it) {
            const int i = tid + NTHREADS * it;
            if (i < 3264) { const int part = i / 1088, rem = i % 1088, row = rem >> 4, ch = rem & 15; *(LAS u32x4_t*)(inp[part] + row * 272 + ch * 16) = st[it]; }
        }
    }
    __syncthreads();
    if (VAR != 4) {
        const int tok = tid >> 3, cg = tid & 7;
#pragma unroll
        for (int pp = 0; pp < 3; ++pp) {
            float acc[16];
#pragma unroll
            for (int e = 0; e < 16; ++e) acc[e] = 0.f;
#pragma unroll
            for (int j = 0; j < 5; ++j) {
                float x[16]; const LAS unsigned char* rp = inp[pp] + (tok + j) * 272 + cg * 32;
                unpack8(*(const LAS u32x4_t*)rp, x); unpack8(*(const LAS u32x4_t*)(rp + 16), x + 8);
#pragma unroll
                for (int e4 = 0; e4 < 4; ++e4) { const f32x4_t w = *(const LAS f32x4_t*)(cwl + j * 384 + pp * 128 + cg * 16 + 4 * e4);
                    acc[4 * e4] += w.x * x[4 * e4]; acc[4 * e4 + 1] += w.y * x[4 * e4 + 1]; acc[4 * e4 + 2] += w.z * x[4 * e4 + 2]; acc[4 * e4 + 3] += w.w * x[4 * e4 + 3]; }
            }
#pragma unroll
            for (int e = 0; e < 16; ++e) acc[e] = silu_f(acc[e]);
            if (pp < 2) {
                float ss = 0.f;
#pragma unroll
                for (int e = 0; e < 16; ++e) ss += acc[e] * acc[e];
                ss += __shfl_xor(ss, 1); ss += __shfl_xor(ss, 2); ss += __shfl_xor(ss, 4);
                float rn = rsqrtf(ss + EPS); if (pp == 0) rn *= 0.08838834764831845f;
#pragma unroll
                for (int e = 0; e < 16; ++e) acc[e] *= rn;
            }
            LAS unsigned char* tile = (pp == 0 ? QT : (pp == 1 ? KT : VT)) + tok * TP + cg * 32;
            *(LAS u32x4_t*)tile = pack8(acc); *(LAS u32x4_t*)(tile + 16) = pack8(acc + 8);
        }
    }
    __syncthreads();
#pragma unroll
    for (int which = 0; which < 2; ++which) {
        LAS unsigned char* X = which ? QT : KT; LAS float* M = which ? QKm : Gm;
#pragma unroll
        for (int tt = 0; tt < 2; ++tt) {
            const int ti = 2 * wave + tt, mt = ti >> 2, nt = ti & 3;
            f32x4_s acc = {0.f, 0.f, 0.f, 0.f};
#pragma unroll
            for (int ks = 0; ks < 4; ++ks) {
                const bf16x8_s a = *(const LAS bf16x8_s*)(X + (16 * mt + (lane & 15)) * TP + 64 * ks + 16 * (lane >> 4));
                const bf16x8_s bq = *(const LAS bf16x8_s*)(KT + (16 * nt + (lane & 15)) * TP + 64 * ks + 16 * (lane >> 4));
                acc = __builtin_amdgcn_mfma_f32_16x16x32_bf16(a, bq, acc, 0, 0, 0);
            }
#pragma unroll
            for (int i = 0; i < 4; ++i) M[(16 * mt + 4 * (lane >> 4) + i) * 68 + 16 * nt + (lane & 15)] = acc[i];
        }
    }
    __syncthreads();
    {
        const int d = tid >> 8, r = tid & 255, pp = r >> 2, jb = (r & 3) * 16, tip = d ? 63 - pp : pp;
        const float bp = SC[128 + d * 64 + pp], gp = SC[d * 64 + pp];
#pragma unroll
        for (int e4 = 0; e4 < 4; ++e4) {
            float v[4];
#pragma unroll
            for (int e = 0; e < 4; ++e) { const int j2 = jb + 4 * e4 + e, tj2 = d ? 63 - j2 : j2;
                v[e] = (j2 < pp) ? bp * Gm[tip * 68 + tj2] * __expf(gp - SC[d * 64 + j2]) : 0.f; }
            *(LAS f32x4_t*)(AM + (d * 64 + pp) * 64 + jb + 4 * e4) = (f32x4_t){v[0], v[1], v[2], v[3]};
        }
    }
    if (VAR != 3) {
#pragma unroll
    for (int it = 0; it < 2; ++it) {
        const int id = tid + 512 * it, d = id >> 9, pp = (id >> 3) & 63, chn = id & 7, tip = d ? 63 - pp : pp;
        const float gp = SC[d * 64 + pp]; float v[8];
#pragma unroll
        for (int j = 0; j < 8; ++j) { const int p2 = 32 * (chn >> 2) + act32(8 * (chn & 3) + j), ti2 = d ? 63 - p2 : p2;
            v[j] = (p2 <= pp) ? QKm[tip * 68 + ti2] * __expf(gp - SC[d * 64 + p2]) : 0.f; }
        *(u32x4_t*)(blob0 + (size_t)d * NCHUNK * BLOB + BL_AQK + pp * 128 + chn * 16) = pack8(v);
    }
#pragma unroll
    for (int it = 0; it < 4; ++it) {
        const int id = tid + 512 * it, d = id >> 10, pp = (id >> 4) & 63, chn = id & 15, tip = d ? 63 - pp : pp;
        const float eg = SC[256 + d * 64 + pp]; float v[8];
        const LAS bf16_raw* qrow = (const LAS bf16_raw*)(QT + tip * TP) + 32 * (chn >> 2) + 4 * (chn & 3);
#pragma unroll
        for (int j = 0; j < 4; ++j) { v[j] = bf2f(qrow[j]) * eg; v[4 + j] = bf2f(qrow[16 + j]) * eg; }
        *(u32x4_t*)(blob0 + (size_t)d * NCHUNK * BLOB + BL_QG + pp * 256 + chn * 16) = pack8(v);
    }
#pragma unroll
    for (int it = 0; it < 4; ++it) {
        const int id = tid + 512 * it, d = id >> 10, dk = (id >> 3) & 127, chn = id & 7;
        const float gl = SC[d * 64 + 63]; float v[8];
#pragma unroll
        for (int j = 0; j < 8; ++j) { const int p2 = 32 * (chn >> 2) + act32(8 * (chn & 3) + j), ti2 = d ? 63 - p2 : p2;
            v[j] = bf2f(((const LAS bf16_raw*)(KT + ti2 * TP))[dk]) * __expf(gl - SC[d * 64 + p2]); }
        *(u32x4_t*)(blob0 + (size_t)d * NCHUNK * BLOB + BL_KDT + dk * 128 + chn * 16) = pack8(v);
    }
    }
    if ((tid & 255) == 0) { const int d = tid >> 8; *(float*)(blob0 + (size_t)d * NCHUNK * BLOB + BL_GE) = SC[256 + d * 64 + 63]; }
    __syncthreads();
    LAS float* DM = (LAS float*)(lds + 69632 + 32768);
    if (VAR != 2) {
    if (tid < 128) {
        const int d = tid >> 6, blk = (tid >> 4) & 3, colj = tid & 15;
        const LAS float* Ab = AM + (d * 64 + 16 * blk) * 64 + 16 * blk;
        float y[16];
#pragma unroll
        for (int r = 0; r < 16; ++r) {
            float acc = (r == colj) ? 1.f : 0.f;
#pragma unroll
            for (int s2 = 0; s2 < r; ++s2) acc -= Ab[r * 64 + s2] * y[s2];
            y[r] = acc;
        }
#pragma unroll
        for (int r = 0; r < 16; ++r) DM[((d * 4 + blk) * 16 + r) * 16 + colj] = y[r];
    }
    __syncthreads();
    {
        const int d = wave >> 2, w4 = wave & 3, l15 = lane & 15, q = lane >> 4;
        bf16x8_s fa10, fa2, fa3a, fa3b, fd[4];
#define BLK4(i_, j_) (*(const LAS f32x4_t*)(AM + (d * 64 + 16 * (i_) + l15) * 64 + 16 * (j_) + 4 * q))
#define MKFRAG(OUT, LO, HI, SGN) do { u32x4_t w_; w_.x = cvtpk_b(SGN LO.x, SGN LO.y); w_.y = cvtpk_b(SGN LO.z, SGN LO.w); w_.z = cvtpk_b(SGN HI.x, SGN HI.y); w_.w = cvtpk_b(SGN HI.z, SGN HI.w); OUT = *reinterpret_cast<bf16x8_s*>(&w_); } while (0)
        const f32x4_t zero4 = {0.f, 0.f, 0.f, 0.f};
        { const f32x4_t a = BLK4(1, 0); MKFRAG(fa10, a, zero4, -); }
        { const f32x4_t a = BLK4(2, 0), b2 = BLK4(2, 1); MKFRAG(fa2, a, b2, -); }
        { const f32x4_t a = BLK4(3, 0), b2 = BLK4(3, 1); MKFRAG(fa3a, a, b2, -); }
        { const f32x4_t a = BLK4(3, 2); MKFRAG(fa3b, a, zero4, -); }
#pragma unroll
        for (int i = 0; i < 4; ++i) { const f32x4_t dd = *(const LAS f32x4_t*)(DM + ((d * 4 + i) * 16 + l15) * 16 + 4 * q); MKFRAG(fd[i], dd, zero4, +); }
#undef BLK4
#pragma unroll
        for (int tt = 0; tt < 4; ++tt) {
            const int nt = 4 * w4 + tt;
            const bool isw = nt >= 8;
            const LAS bf16_raw* colp = (isw ? (const LAS bf16_raw*)KT + 16 * (nt - 8) : (const LAS bf16_raw*)VT + 16 * nt) + l15;
            f32x4_s R[4];
#pragma unroll
            for (int i = 0; i < 4; ++i)
#pragma unroll
                for (int e = 0; e < 4; ++e) { const int pp = 16 * i + 4 * q + e, tip = d ? 63 - pp : pp;
                    const float sc = SC[128 + d * 64 + pp] * (isw ? SC[256 + d * 64 + pp] : 1.f); R[i][e] = sc * bf2f(colp[tip * (TP / 2)]); }
            f32x4_s X[4]; bf16x8_s xb01, xb2;
            const f32x4_s z4 = {0.f, 0.f, 0.f, 0.f};
#define ACC2B(OUT, LO, HI) do { u32x4_t w_; w_.x = cvtpk_b(LO[0], LO[1]); w_.y = cvtpk_b(LO[2], LO[3]); w_.z = cvtpk_b(HI[0], HI[1]); w_.w = cvtpk_b(HI[2], HI[3]); OUT = *reinterpret_cast<bf16x8_s*>(&w_); } while (0)
            bf16x8_s yb;
            ACC2B(yb, R[0], z4); X[0] = __builtin_amdgcn_mfma_f32_16x16x32_bf16(fd[0], yb, z4, 0, 0, 0);
            { bf16x8_s xb0; ACC2B(xb0, X[0], z4); f32x4_s y1 = __builtin_amdgcn_mfma_f32_16x16x32_bf16(fa10, xb0, R[1], 0, 0, 0);
              ACC2B(yb, y1, z4); X[1] = __builtin_amdgcn_mfma_f32_16x16x32_bf16(fd[1], yb, z4, 0, 0, 0); }
            ACC2B(xb01, X[0], X[1]);
            { f32x4_s y2 = __builtin_amdgcn_mfma_f32_16x16x32_bf16(fa2, xb01, R[2], 0, 0, 0);
              ACC2B(yb, y2, z4); X[2] = __builtin_amdgcn_mfma_f32_16x16x32_bf16(fd[2], yb, z4, 0, 0, 0); }
            ACC2B(xb2, X[2], z4);
            { f32x4_s y3 = __builtin_amdgcn_mfma_f32_16x16x32_bf16(fa3a, xb01, R[3], 0, 0, 0); y3 = __builtin_amdgcn_mfma_f32_16x16x32_bf16(fa3b, xb2, y3, 0, 0, 0);
              ACC2B(yb, y3, z4); X[3] = __builtin_amdgcn_mfma_f32_16x16x32_bf16(fd[3], yb, z4, 0, 0, 0); }
#undef ACC2B
            if (!isw) {
                u32x4_t w0, w1;
                w0.x = cvtpk_b(X[0][0], X[0][1]); w0.y = cvtpk_b(X[0][2], X[0][3]); w0.z = cvtpk_b(X[1][0], X[1][1]); w0.w = cvtpk_b(X[1][2], X[1][3]);
                w1.x = cvtpk_b(X[2][0], X[2][1]); w1.y = cvtpk_b(X[2][2], X[2][3]); w1.z = cvtpk_b(X[3][0], X[3][1]); w1.w = cvtpk_b(X[3][2], X[3][3]);
                unsigned char* dst = blob0 + (size_t)d * NCHUNK * BLOB + BL_U + (nt * 64 + lane) * 32;
                *(u32x4_t*)dst = w0; *(u32x4_t*)(dst + 16) = w1;
            } else {
                const int dk = 16 * (nt - 8) + l15; LAS bf16_raw* xt = XT + d * 8192 + (dk & ~31) + pos32(dk & 31);
#pragma unroll
                for (int i = 0; i < 4; ++i)
#pragma unroll
                    for (int e = 0; e < 4; ++e) xt[(16 * i + 4 * q + e) * 128] = f2bf_rne(-X[i][e]);
            }
        }
#undef MKFRAG
    }
    }
    __syncthreads();
#pragma unroll
    for (int it = 0; it < 4; ++it) {
        const int id = tid + 512 * it, d = id >> 10, r = id & 1023;
        *(u32x4_t*)(blob0 + (size_t)d * NCHUNK * BLOB + BL_WN + r * 16) = *(const LAS u32x4_t*)(XT + d * 8192 + r * 8);
    }
}
__device__ __forceinline__ void phase_bprep(const Params& p, LAS unsigned char* lds) {
    for (int u = blockIdx.x; u < 2 * 4 * NCHUNK; u += gridDim.x) bprep_unit<0>(p, lds, u);
    if (PROBE >= 31 && PROBE <= 34) for (int u = blockIdx.x; u < 2 * 4 * NCHUNK; u += gridDim.x) bprep_unit<PROBE - 30 < 0 ? 0 : (PROBE >= 31 && PROBE <= 34 ? PROBE - 30 : 0)>(p, lds, u);
}

constexpr int SCAN_NSPLIT = 8;
constexpr int SCAN_NCW = 8 / SCAN_NSPLIT;
static_assert(SCAN_NSPLIT == 2 || SCAN_NSPLIT == 4 || SCAN_NSPLIT == 8, "scan split");
template <int VAR>
__device__ __forceinline__ void scan_chain(const Params& p, LAS unsigned char* lds, int chain, int half) {
    const int tid = opaque_tid(), lane = tid & 63, wave = __builtin_amdgcn_readfirstlane(tid >> 6);
    unsigned char* ws = launder(p.ws);
    const int b = chain >> 3, dir = (chain >> 2) & 1, h = chain & 3;
    const unsigned char* blobs = ws + WS_BLOB + (size_t)(((b * 4 + h) * 2 + dir) * NCHUNK) * BLOB;
    unsigned char* snaps = ws + WS_SNAP + (size_t)(((b * 4 + h) * 2 + dir) * NCHUNK) * SNAP;
    constexpr int BUF = 44032, O_WN = 0, O_KDT = 17408, O_U = 35840, O_GE = 2 * BUF;
#define SCAN_CHUNK(n) (dir == 0 ? (n) : ((n) < 4 ? 3 - (n) : 135 - (n)))
    __syncthreads();
    if (wave >= 4) {
        const int lt = tid - 256;
        u32x4_t r0[10], r1[10], r2[10];
#define SCAN_LOAD(R, n) do { { const int nn_ = (n) < NCHUNK ? (n) : NCHUNK - 1; const unsigned char* src = blobs + (size_t)SCAN_CHUNK(nn_) * BLOB + lt * 16;     \
            _Pragma("unroll") for (int i = 0; i < 4; ++i) { R[i] = *(const u32x4_t*)(src + BL_WN + i * 4096); R[4 + i] = *(const u32x4_t*)(src + BL_KDT + i * 4096); } \
            if (SCAN_NCW == 4) { R[8] = *(const u32x4_t*)(src + BL_U + half * 8192); R[9] = *(const u32x4_t*)(src + BL_U + half * 8192 + 4096); } \
            else if (SCAN_NCW == 2) R[8] = *(const u32x4_t*)(src + BL_U + half * 4096); \
            else if (lt < 128) R[8] = *(const u32x4_t*)(src + BL_U + half * 2048); } } while (0)
#define SCAN_WRITE(bufi, R) do { LAS unsigned char* dst = lds + (bufi) * BUF; _Pragma("unroll") for (int i = 0; i < 4; ++i) { const int g = lt + 256 * i; \
            *(LAS u32x4_t*)(dst + O_WN + (g >> 4) * 272 + (g & 15) * 16) = R[i]; *(LAS u32x4_t*)(dst + O_KDT + (g >> 3) * 144 + (g & 7) * 16) = R[4 + i]; } \
            if (SCAN_NCW > 1 || lt < 128) *(LAS u32x4_t*)(dst + O_U + lt * 16) = R[8]; if (SCAN_NCW == 4) *(LAS u32x4_t*)(dst + O_U + 4096 + lt * 16) = R[9]; } while (0)
        if (lt < NCHUNK) ((LAS float*)(lds + O_GE))[lt] = *(const float*)(blobs + (size_t)SCAN_CHUNK(lt) * BLOB + BL_GE);
        SCAN_LOAD(r0, 0); SCAN_LOAD(r1, 1); SCAN_LOAD(r2, 2);
        SCAN_WRITE(0, r0); SCAN_LOAD(r0, 3);
        __syncthreads();
        for (int n = 0; n < NCHUNK; n += 3) {
            SCAN_WRITE((n + 1) & 1, r1);
            SCAN_LOAD(r1, n + 4);
            __syncthreads();
            SCAN_WRITE((n + 2) & 1, r2);
            SCAN_LOAD(r2, n + 5);
            __syncthreads();
            SCAN_WRITE((n + 3) & 1, r0);
            SCAN_LOAD(r0, n + 6);
            __syncthreads();
        }
#undef SCAN_LOAD
#undef SCAN_WRITE
    } else if (wave >= SCAN_NCW) {
        for (int n = 0; n < NCHUNK + 1; ++n) __syncthreads();
    } else {
        const int slice = half * SCAN_NCW + wave, l15 = lane & 15, q = lane >> 4;
        f32x4_s S[8];
#pragma unroll
        for (int m = 0; m < 8; ++m) S[m] = (f32x4_s){0.f, 0.f, 0.f, 0.f};
        const int aoff272 = l15 * 272 + 16 * q, aoff144 = l15 * 144 + 16 * q;
        __syncthreads();
        for (int n = 0; n < NCHUNK; ++n) {
            LAS unsigned char* buf = lds + (n & 1) * BUF;
            const u32x4_t u0 = *(const LAS u32x4_t*)(buf + O_U + (wave * 64 + lane) * 32), u1 = *(const LAS u32x4_t*)(buf + O_U + (wave * 64 + lane) * 32 + 16);
            const float ge = ((const LAS float*)(lds + O_GE))[n];
            u32x4_t sbw[4];
#pragma unroll
            for (int ks = 0; ks < 4; ++ks) { sbw[ks].x = cvtpk_b(S[2 * ks][0], S[2 * ks][1]); sbw[ks].y = cvtpk_b(S[2 * ks][2], S[2 * ks][3]); sbw[ks].z = cvtpk_b(S[2 * ks + 1][0], S[2 * ks + 1][1]); sbw[ks].w = cvtpk_b(S[2 * ks + 1][2], S[2 * ks + 1][3]); }
            unsigned char* snap = snaps + (size_t)n * SNAP + (slice * 64 + lane) * 16;
#pragma unroll
            for (int ks = 0; ks < 4; ++ks) *(u32x4_t*)(snap + ks * 8192) = sbw[ks];
            f32x4_s vn[4];
            { float uu[16]; unpack8(u0, uu); unpack8(u1, uu + 8);
#pragma unroll
              for (int m = 0; m < 4; ++m) vn[m] = (f32x4_s){uu[4 * m], uu[4 * m + 1], uu[4 * m + 2], uu[4 * m + 3]}; }
            bf16x8_s fa[16], fb[16];
#pragma unroll
            for (int m = 0; m < 4; ++m)
#pragma unroll
                for (int ks = 0; ks < 4; ++ks) fa[m * 4 + ks] = *(const LAS bf16x8_s*)(buf + O_WN + m * 16 * 272 + aoff272 + 64 * ks);
#pragma unroll
            for (int m = 0; m < 8; ++m)
#pragma unroll
                for (int ks = 0; ks < 2; ++ks) fb[m * 2 + ks] = *(const LAS bf16x8_s*)(buf + O_KDT + m * 16 * 144 + aoff144 + 64 * ks);
            __builtin_amdgcn_sched_barrier(0);
#pragma unroll
            for (int ks = 0; ks < 4; ++ks)
#pragma unroll
                for (int m = 0; m < 4; ++m) vn[m] = __builtin_amdgcn_mfma_f32_16x16x32_bf16(fa[m * 4 + ks], *reinterpret_cast<bf16x8_s*>(&sbw[ks]), vn[m], 0, 0, 0);
            __builtin_amdgcn_sched_barrier(0);
            u32x4_t vbw[2];
#pragma unroll
            for (int ks = 0; ks < 2; ++ks) { vbw[ks].x = cvtpk_b(vn[2 * ks][0], vn[2 * ks][1]); vbw[ks].y = cvtpk_b(vn[2 * ks][2], vn[2 * ks][3]); vbw[ks].z = cvtpk_b(vn[2 * ks + 1][0], vn[2 * ks + 1][1]); vbw[ks].w = cvtpk_b(vn[2 * ks + 1][2], vn[2 * ks + 1][3]); }
#pragma unroll
            for (int ks = 0; ks < 2; ++ks) *(u32x4_t*)(snap + 32768 + ks * 8192) = vbw[ks];
#pragma unroll
            for (int m = 0; m < 8; ++m) S[m] = S[m] * ge;
#pragma unroll
            for (int ks = 0; ks < 2; ++ks)
#pragma unroll
                for (int m = 0; m < 8; ++m) S[m] = __builtin_amdgcn_mfma_f32_16x16x32_bf16(fb[m * 2 + ks], *reinterpret_cast<bf16x8_s*>(&vbw[ks]), S[m], 0, 0, 0);
            __syncthreads();
        }
    }
#undef SCAN_CHUNK
}

__device__ __forceinline__ void outgate_item(const Params& p, LAS unsigned char* lds, int item) {
    const int tid = opaque_tid(), lane = tid & 63, wave = tid >> 6, l15 = lane & 15, q = lane >> 4;
    unsigned char* ws = launder(p.ws);
    const int b = item / (4 * NCHUNK), h = (item / NCHUNK) & 3, c = item % NCHUNK;
    LAS float* obt = (LAS float*)lds;
    LAS float* sq = (LAS float*)(lds + 64 * 132 * 4);
    LAS unsigned char* At = lds + 36864;
    f32x4_s o[2][4];
    const int rowbase = c < 4 ? MLAT + b * CTXL + 64 * c : b * SEQ + 64 * (c - 4);
    const bf16_raw* Pz = (const bf16_raw*)(ws + WS_P) + (size_t)rowbase * NAB + 2304 + h * 128 + 16 * wave + l15;
    bf16_raw zr[16];
#pragma unroll
    for (int m = 0; m < 4; ++m)
#pragma unroll
        for (int i = 0; i < 4; ++i) zr[4 * m + i] = Pz[(size_t)(16 * m + 4 * q + i) * NAB];
    bf16x8_s sb[2][4], vb[2][2];
    {
        u32x4_t ra[2][3];
#pragma unroll
        for (int d = 0; d < 2; ++d) {
            const int nstep = d == 0 ? c : (c < 4 ? 3 - c : 135 - c);
            const unsigned char* blob = ws + WS_BLOB + (size_t)(((b * 4 + h) * 2 + d) * NCHUNK + c) * BLOB;
            const unsigned char* snap = ws + WS_SNAP + (size_t)(((b * 4 + h) * 2 + d) * NCHUNK + nstep) * SNAP + (wave * 64 + lane) * 16;
            ra[d][0] = *(const u32x4_t*)(blob + BL_QG + tid * 16); ra[d][1] = *(const u32x4_t*)(blob + BL_QG + (tid + 512) * 16); ra[d][2] = *(const u32x4_t*)(blob + BL_AQK + tid * 16);
#pragma unroll
            for (int ks = 0; ks < 4; ++ks) sb[d][ks] = *(const bf16x8_s*)(snap + ks * 8192);
#pragma unroll
            for (int ks = 0; ks < 2; ++ks) vb[d][ks] = *(const bf16x8_s*)(snap + 32768 + ks * 8192);
        }
        __syncthreads();
#pragma unroll
        for (int d = 0; d < 2; ++d) {
            LAS unsigned char* Ad = At + d * 26624;
            *(LAS u32x4_t*)(Ad + (tid >> 4) * 272 + (tid & 15) * 16) = ra[d][0]; *(LAS u32x4_t*)(Ad + ((tid + 512) >> 4) * 272 + (tid & 15) * 16) = ra[d][1];
            *(LAS u32x4_t*)(Ad + 17408 + (tid >> 3) * 144 + (tid & 7) * 16) = ra[d][2];
        }
    }
    __syncthreads();
#pragma unroll
    for (int d = 0; d < 2; ++d) {
        const LAS unsigned char* Ad = At + d * 26624;
        bf16x8_s aq[16], aa[8];
#pragma unroll
        for (int m = 0; m < 4; ++m) {
#pragma unroll
            for (int ks = 0; ks < 4; ++ks) aq[4 * m + ks] = *(const LAS bf16x8_s*)(Ad + (16 * m + l15) * 272 + 64 * ks + 16 * q);
#pragma unroll
            for (int ks = 0; ks < 2; ++ks) aa[2 * m + ks] = *(const LAS bf16x8_s*)(Ad + 17408 + (16 * m + l15) * 144 + 64 * ks + 16 * q);
        }
        __builtin_amdgcn_sched_barrier(0);
#pragma unroll
        for (int m = 0; m < 4; ++m) o[d][m] = (f32x4_s){0.f, 0.f, 0.f, 0.f};
#pragma unroll
        for (int ks = 0; ks < 4; ++ks)
#pragma unroll
            for (int m = 0; m < 4; ++m) o[d][m] = __builtin_amdgcn_mfma_f32_16x16x32_bf16(aq[4 * m + ks], sb[d][ks], o[d][m], 0, 0, 0);
#pragma unroll
        for (int ks = 0; ks < 2; ++ks)
#pragma unroll
            for (int m = 0; m < 4; ++m) o[d][m] = __builtin_amdgcn_mfma_f32_16x16x32_bf16(aa[2 * m + ks], vb[d][ks], o[d][m], 0, 0, 0);
        __builtin_amdgcn_sched_barrier(0);
    }
    __syncthreads();
#pragma unroll
    for (int m = 0; m < 4; ++m)
#pragma unroll
        for (int i = 0; i < 4; ++i) obt[(16 * m + 4 * q + i) * 132 + 16 * wave + l15] = o[1][m][i];
    __syncthreads();
    float x[16], ssq[16];
#pragma unroll
    for (int m = 0; m < 4; ++m)
#pragma unroll
        for (int i = 0; i < 4; ++i) { const int pp = 16 * m + 4 * q + i; const float v = o[0][m][i] + obt[(63 - pp) * 132 + 16 * wave + l15]; x[4 * m + i] = v; ssq[4 * m + i] = v * v; }
#pragma unroll
    for (int k = 0; k < 16; ++k) { float t = ssq[k]; t += __shfl_xor(t, 1); t += __shfl_xor(t, 2); t += __shfl_xor(t, 4); t += __shfl_xor(t, 8); ssq[k] = t; }
    if (l15 == 0) {
#pragma unroll
        for (int m = 0; m < 4; ++m)
#pragma unroll
            for (int i = 0; i < 4; ++i) sq[wave * 64 + 16 * m + 4 * q + i] = ssq[4 * m + i];
    }
    __syncthreads();
    bf16_raw* OAB = (bf16_raw*)(ws + WS_OAB);
    const int col = h * 128 + 16 * wave + l15; const float on = p.in[I_ONORM][16 * wave + l15];
#pragma unroll
    for (int m = 0; m < 4; ++m)
#pragma unroll
        for (int i = 0; i < 4; ++i) {
            const int pp = 16 * m + 4 * q + i;
            float t = 0.f;
#pragma unroll
            for (int w = 0; w < 8; ++w) t += sq[w * 64 + pp];
            const float rms = rsqrtf(t * (1.f / 128.f) + EPS);
            const size_t row = (size_t)(rowbase + pp);
            const float z = bf2f(zr[4 * m + i]);
            OAB[row * DM + 512 + col] = f2bf_rne(x[4 * m + i] * rms * on * silu_f(z));
        }
}
__device__ __forceinline__ void phase_outgate(const Params& p, LAS unsigned char* lds) {
    for (int it = blockIdx.x; it < 2 * 4 * NCHUNK; it += gridDim.x) outgate_item(p, lds, it);
}

__device__ __forceinline__ void mini_resid_tile(const bf16_raw* A, const bf16_raw* Bt, const float* res, const float* gate, float* out, int row0, int col0) {
    const int tid = opaque_tid(), lane = tid & 63, wave = tid >> 6, l15 = lane & 15, q = lane >> 4;
    const int r0 = row0 + 16 * (wave >> 1), c0 = col0 + 16 * (wave & 1);
    const bf16_raw* ap = A + (size_t)(r0 + l15) * DM + 8 * q;
    const bf16_raw* bp = Bt + (size_t)(c0 + l15) * DM + 8 * q;
    f32x4_s acc = {0.f, 0.f, 0.f, 0.f};
#pragma unroll 1
    for (int k0 = 0; k0 < DM; k0 += 256) {
        bf16x8_s af[8], bfr[8];
#pragma unroll
        for (int j = 0; j < 8; ++j) { af[j] = *(const bf16x8_s*)(ap + k0 + 32 * j); bfr[j] = *(const bf16x8_s*)(bp + k0 + 32 * j); }
#pragma unroll
        for (int j = 0; j < 8; ++j) acc = __builtin_amdgcn_mfma_f32_16x16x32_bf16(af[j], bfr[j], acc, 0, 0, 0);
    }
    const int c = c0 + l15; const float gv = gate[c];
#pragma unroll
    for (int i = 0; i < 4; ++i) { const size_t o = (size_t)(r0 + 4 * q + i) * DM + c; out[o] = res[o] + gv * acc[i]; }
}

__device__ __forceinline__ void moe2_ctx_piece(const bf16_raw* HIDe, const bf16_raw* W2e  , const float* GATEe, bf16_raw* YEe, int ct) {
    const int tid = opaque_tid(), lane = tid & 63, wave = tid >> 6, l15 = lane & 15, q = lane >> 4;
    const int rt = wave >> 1, n0 = 32 * ct + 16 * (wave & 1);
    const bf16_raw* ap = HIDe + (size_t)(2 * CAPL + 16 * rt + l15) * FF + 8 * q;
    const bf16_raw* bp = W2e + (size_t)(n0 + l15) * FF + 8 * q;
    f32x4_s acc = {0.f, 0.f, 0.f, 0.f};
    bf16x8_s af[8], bfr[8], an[8], bn[8];
#pragma unroll
    for (int j = 0; j < 8; ++j) { af[j] = *(const bf16x8_s*)(ap + 32 * j); bfr[j] = *(const bf16x8_s*)(bp + 32 * j); }
#pragma unroll 1
    for (int k0 = 0; k0 < FF; k0 += 256) {
        if (k0 + 256 < FF) {
#pragma unroll
            for (int j = 0; j < 8; ++j) { an[j] = *(const bf16x8_s*)(ap + k0 + 256 + 32 * j); bn[j] = *(const bf16x8_s*)(bp + k0 + 256 + 32 * j); }
        }
#pragma unroll
        for (int j = 0; j < 8; ++j) acc = __builtin_amdgcn_mfma_f32_16x16x32_bf16(af[j], bfr[j], acc, 0, 0, 0);
#pragma unroll
        for (int j = 0; j < 8; ++j) { af[j] = an[j]; bfr[j] = bn[j]; }
    }
#pragma unroll
    for (int i = 0; i < 4; ++i) { const int r = 2 * CAPL + 16 * rt + 4 * q + i; YEe[(size_t)r * DM + n0 + l15] = f2bf_rne(acc[i] * GATEe[r]); }
}

__device__ __forceinline__ int block_excl_scan(int v, LAS int* tmp, int tid) {
    const int lane = tid & 63, w = tid >> 6; int x = v;
#pragma unroll
    for (int o = 1; o < 64; o <<= 1) { const int y = __shfl_up(x, o); if (lane >= o) x += y; }
    __syncthreads();
    if (lane == 63) tmp[w] = x;
    __syncthreads();
    int off = 0;
    for (int i = 0; i < w; ++i) off += tmp[i];
    return off + x - v;
}
__device__ __forceinline__ void topk_select(const float* aff, int n, int cap, int e, int slot0, int row0, int* IDX, float* GATE, int* INV, LAS unsigned char* lds) {
    const int tid = opaque_tid();
    LAS unsigned* sv = (LAS unsigned*)lds; LAS unsigned* hist = sv + 8192; LAS int* misc = (LAS int*)(hist + 256); LAS int* tmp = misc + 16;
    __syncthreads();
    for (int i = tid; i < n; i += NTHREADS) sv[i] = __float_as_uint(aff[i]);
    unsigned prefix = 0u, mask = 0u; int kth = cap;
    for (int pass = 3; pass >= 0; --pass) {
        const int shift = 8 * pass;
        if (tid < 256) hist[tid] = 0u;
        __syncthreads();
        for (int i = tid; i < n; i += NTHREADS) { const unsigned v = sv[i]; if ((v & mask) == prefix) atomicAdd((unsigned*)&hist[(v >> shift) & 255u], 1u); }
        __syncthreads();
        if (tid < 64) {
            const int c0 = (int)hist[255 - 4 * tid], c1 = (int)hist[254 - 4 * tid], c2 = (int)hist[253 - 4 * tid], c3 = (int)hist[252 - 4 * tid];
            const int tot = c0 + c1 + c2 + c3; int incl = tot;
#pragma unroll
            for (int o = 1; o < 64; o <<= 1) { const int y = __shfl_up(incl, o); if (tid >= o) incl += y; }
            const int excl = incl - tot;
            if (excl < kth && kth <= incl) {
                int cum = excl, bsel, rem;
                if (cum + c0 >= kth) { bsel = 255 - 4 * tid; rem = kth - cum; }
                else { cum += c0; if (cum + c1 >= kth) { bsel = 254 - 4 * tid; rem = kth - cum; }
                else { cum += c1; if (cum + c2 >= kth) { bsel = 253 - 4 * tid; rem = kth - cum; }
                else { cum += c2; bsel = 252 - 4 * tid; rem = kth - cum; } } }
                misc[0] = bsel; misc[1] = rem;
            }
        }
        __syncthreads();
        prefix |= (unsigned)misc[0] << shift; kth = misc[1]; mask |= 0xffu << shift;
        __syncthreads();
    }
    const unsigned T = prefix; const int need_eq = kth;
    const int per = (n + NTHREADS - 1) / NTHREADS, i0 = tid * per, i1 = (i0 + per < n) ? i0 + per : n;
    int cgt = 0, ceq = 0;
    for (int i = i0; i < i1; ++i) { const unsigned v = sv[i]; cgt += (v > T); ceq += (v == T); }
    const int eq_before = block_excl_scan(ceq, tmp, tid);
    int myeq = need_eq - eq_before; myeq = myeq < 0 ? 0 : (myeq > ceq ? ceq : myeq);
    int slot = block_excl_scan(cgt + myeq, tmp, tid);
    int eqr = eq_before;
    for (int i = i0; i < i1; ++i) {
        const unsigned v = sv[i]; bool sel = v > T;
        if (v == T) { sel = eqr < need_eq; ++eqr; }
        if (sel) { const int rs = slot0 + slot; IDX[e * EROWS + rs] = row0 + i; GATE[e * EROWS + rs] = __uint_as_float(v); INV[(size_t)(row0 + i) * 16 + e] = rs; ++slot; }
        else INV[(size_t)(row0 + i) * 16 + e] = -1;
    }
}
__device__ __forceinline__ void phase_select(const Params& p, LAS unsigned char* lds, bool with_ctx) {
    unsigned char* ws = launder(p.ws);
    const float* AFF = (const float*)(ws + WS_AFF); int* IDX = (int*)(ws + WS_IDX); float* GATE = (float*)(ws + WS_GATE); int* INV = (int*)(ws + WS_INV);
    const int nitems = with_ctx ? 64 : 32;
    for (int it = blockIdx.x; it < nitems; it += gridDim.x) {
        if (it < 32) { const int b = it >> 4, e = it & 15;
            topk_select(AFF + (size_t)(b * 16 + e) * SEQ, SEQ, CAPL, e, b * CAPL, b * SEQ, IDX, GATE, INV, lds);
            if (b == 0) for (int i = 2 * CAPL + 2 * CAPC + opaque_tid(); i < EROWS; i += NTHREADS) { IDX[e * EROWS + i] = -1; GATE[e * EROWS + i] = 0.f; }
            if (b == 1 && !with_ctx) for (int i = 2 * CAPL + opaque_tid(); i < 2 * CAPL + 2 * CAPC; i += NTHREADS) { IDX[e * EROWS + i] = -1; GATE[e * EROWS + i] = 0.f; }
        } else { const int b = (it - 32) >> 4, e = it & 15;
            topk_select(AFF + (size_t)2 * 16 * SEQ + (size_t)(b * 16 + e) * CTXL, CTXL, CAPC, e, 2 * CAPL + b * CAPC, MLAT + b * CTXL, IDX, GATE, INV, lds); }
    }
}
__device__ __forceinline__ void phase_gather(const Params& p, int rows_per_e) {
    const int tid = opaque_tid(), lane = tid & 63, wave = tid >> 6;
    unsigned char* ws = launder(p.ws);
    const int* IDX = (const int*)(ws + WS_IDX); const bf16_raw* H2 = (const bf16_raw*)(ws + WS_H2); bf16_raw* XG = (bf16_raw*)(ws + WS_XG);
    const int gw = blockIdx.x * NWAVES + wave, NGW = gridDim.x * NWAVES, total = NEXP * rows_per_e;
    for (int i0 = gw; i0 < total; i0 += 4 * NGW) {
        int src[4]; size_t dsto[4];
#pragma unroll
        for (int k = 0; k < 4; ++k) { const int i = i0 + k * NGW; src[k] = -2; dsto[k] = 0;
            if (i < total) { const int e = i / rows_per_e, sl = i % rows_per_e; src[k] = IDX[e * EROWS + sl]; dsto[k] = ((size_t)e * EROWS + sl) * DM; } }
        u32x4_t a[4], c[4];
#pragma unroll
        for (int k = 0; k < 4; ++k) { a[k] = (u32x4_t){0u, 0u, 0u, 0u}; c[k] = a[k];
            if (src[k] >= 0) { a[k] = *(const u32x4_t*)(H2 + (size_t)src[k] * DM + 8 * lane); c[k] = *(const u32x4_t*)(H2 + (size_t)src[k] * DM + 512 + 8 * lane); } }
#pragma unroll
        for (int k = 0; k < 4; ++k) if (src[k] != -2) { *(u32x4_t*)(XG + dsto[k] + 8 * lane) = a[k]; *(u32x4_t*)(XG + dsto[k] + 512 + 8 * lane) = c[k]; }
    }
}
template <bool FINAL>
__device__ __forceinline__ void phase_combine(const Params& p, int layer) {
    const int tid = opaque_tid(), lane = tid & 63, wave = tid >> 6;
    unsigned char* ws = launder(p.ws);
    const float* XA = (const float*)(ws + WS_XA); float* XB = (float*)(ws + WS_XB); const int* INV = (const int*)(ws + WS_INV);
    const bf16_raw* YE = (const bf16_raw*)(ws + WS_YE); const float* MOD = (const float*)(ws + WS_MOD); bf16_raw* H = (bf16_raw*)(ws + WS_H);
    const int gw = blockIdx.x * NWAVES + wave, NGW = gridDim.x * NWAVES, nrows = FINAL ? MLAT : MALL;
    f32x4_t v[4], vn[4]; int myinv = -1, myinvn = -1;
    u32x2_t w0[4], w1[4]; float f0 = 0.f, f1 = 0.f; unsigned long long mask = 0ull;
#define COMB_FIRST_PAIR(INVV) do { mask = __ballot((INVV) >= 0) & 0xffffull; f0 = 0.f; f1 = 0.f; int e0_ = 0, e1_ = 0; \
        if (mask) { e0_ = __builtin_ctzll(mask); mask &= mask - 1; f0 = 1.f; e1_ = e0_; if (mask) { e1_ = __builtin_ctzll(mask); mask &= mask - 1; f1 = 1.f; } } \
        const int s0_ = __shfl((INVV), e0_), s1_ = __shfl((INVV), e1_); \
        const bf16_raw* y0_ = YE + ((size_t)e0_ * EROWS + (s0_ < 0 ? 0 : s0_)) * DM; const bf16_raw* y1_ = YE + ((size_t)e1_ * EROWS + (s1_ < 0 ? 0 : s1_)) * DM; \
        _Pragma("unroll") for (int j = 0; j < 4; ++j) { w0[j] = *(const u32x2_t*)(y0_ + 4 * lane + 256 * j); w1[j] = *(const u32x2_t*)(y1_ + 4 * lane + 256 * j); } } while (0)
    int r = gw;
    if (r < nrows) {
#pragma unroll
        for (int j = 0; j < 4; ++j) v[j] = *(const f32x4_t*)(XA + (size_t)r * DM + 4 * lane + 256 * j);
        myinv = (lane < 16) ? INV[(size_t)r * 16 + lane] : -1;
        COMB_FIRST_PAIR(myinv);
    }
    for (; r < nrows; r += NGW) {
        const int rn = r + NGW;
        if (rn < nrows) {
#pragma unroll
            for (int j = 0; j < 4; ++j) vn[j] = *(const f32x4_t*)(XA + (size_t)rn * DM + 4 * lane + 256 * j);
            myinvn = (lane < 16) ? INV[(size_t)rn * 16 + lane] : -1; }
        f32x4_t acc[4];
#pragma unroll
        for (int j = 0; j < 4; ++j) {
            acc[j].x = f0 * bf2f(w0[j].x & 0xffffu) + f1 * bf2f(w1[j].x & 0xffffu); acc[j].y = f0 * bf2f(w0[j].x >> 16) + f1 * bf2f(w1[j].x >> 16);
            acc[j].z = f0 * bf2f(w0[j].y & 0xffffu) + f1 * bf2f(w1[j].y & 0xffffu); acc[j].w = f0 * bf2f(w0[j].y >> 16) + f1 * bf2f(w1[j].y >> 16); }
        while (mask) {
            const int e0 = __builtin_ctzll(mask); mask &= mask - 1;
            int e1 = -1; if (mask) { e1 = __builtin_ctzll(mask); mask &= mask - 1; }
            const bf16_raw* y0 = YE + ((size_t)e0 * EROWS + __shfl(myinv, e0)) * DM;
            const bf16_raw* y1 = YE + ((size_t)(e1 < 0 ? e0 : e1) * EROWS + __shfl(myinv, e1 < 0 ? e0 : e1)) * DM;
            u32x2_t x0[4], x1[4];
#pragma unroll
            for (int j = 0; j < 4; ++j) { x0[j] = *(const u32x2_t*)(y0 + 4 * lane + 256 * j); x1[j] = *(const u32x2_t*)(y1 + 4 * lane + 256 * j); }
            const float g1 = e1 < 0 ? 0.f : 1.f;
#pragma unroll
            for (int j = 0; j < 4; ++j) {
                acc[j].x += bf2f(x0[j].x & 0xffffu); acc[j].y += bf2f(x0[j].x >> 16); acc[j].z += bf2f(x0[j].y & 0xffffu); acc[j].w += bf2f(x0[j].y >> 16);
                acc[j].x += g1 * bf2f(x1[j].x & 0xffffu); acc[j].y += g1 * bf2f(x1[j].x >> 16); acc[j].z += g1 * bf2f(x1[j].y & 0xffffu); acc[j].w += g1 * bf2f(x1[j].y >> 16); }
        }
        if (rn < nrows) COMB_FIRST_PAIR(myinvn);
        const int vsel = (r < MLAT) ? (r >> 13) : 2;
        const float* gt2 = MOD + (size_t)(layer * 3 + vsel) * 6144 + 5120;
#pragma unroll
        for (int j = 0; j < 4; ++j) v[j] = v[j] + *(const f32x4_t*)(gt2 + 4 * lane + 256 * j) * acc[j];
        if (FINAL) {
#pragma unroll
            for (int j = 0; j < 4; ++j) *(f32x4_t*)(p.out + (size_t)r * DM + 4 * lane + 256 * j) = v[j];
        } else {
#pragma unroll
            for (int j = 0; j < 4; ++j) *(f32x4_t*)(XB + (size_t)r * DM + 4 * lane + 256 * j) = v[j];
            norm_apply(v, p.in[I_NMIX] + 1024, MOD + (size_t)(3 + vsel) * 6144, lane);
            store_h(v, H + (size_t)r * DM, lane);
        }
#pragma unroll
        for (int j = 0; j < 4; ++j) v[j] = vn[j];
        myinv = myinvn;
    }
#undef COMB_FIRST_PAIR
}

__device__ __forceinline__ void phase_prep1(const Params& p) {
    const int tid = opaque_tid(), lane = tid & 63, wave = tid >> 6;
    unsigned char* ws = launder(p.ws);
    const bf16_raw* P = (const bf16_raw*)(ws + WS_P);
    bf16_raw* QC = (bf16_raw*)(ws + WS_QA); bf16_raw* KC = (bf16_raw*)(ws + WS_KA); bf16_raw* VC = (bf16_raw*)(ws + WS_VA);
    const f32x2_t* tab = (const f32x2_t*)(ws + WS_ROPE) + 128 * 16;
    const int gw = blockIdx.x * NWAVES + wave, NGW = gridDim.x * NWAVES;
    const int hl0 = 16 * (lane & 7);
    float qn[16], kn[16];
#pragma unroll
    for (int e = 0; e < 16; ++e) { qn[e] = p.in[I_QNC][hl0 + e]; kn[e] = p.in[I_KNC][hl0 + e]; }
    u32x4_t q0, q1, k0, k1, nq0 = {0u, 0u, 0u, 0u}, nq1 = nq0, nk0 = nq0, nk1 = nq0;
#define PREP1_LOAD(rr, Q0, Q1, K0, K1) do { const bf16_raw* prow = P + (size_t)(rr) * NC; if ((rr) < MLAT) { Q0 = *(const u32x4_t*)(prow + 16 * lane); Q1 = *(const u32x4_t*)(prow + 16 * lane + 8); } \
        K0 = *(const u32x4_t*)(prow + 1024 + 16 * (lane & 31)); K1 = *(const u32x4_t*)(prow + 1024 + 16 * (lane & 31) + 8); } while (0)
    int r = gw;
    q0 = nq0; q1 = nq0; k0 = nq0; k1 = nq0;
    if (r < MALL) PREP1_LOAD(r, q0, q1, k0, k1);
    for (; r < MALL; r += NGW) {
        const int rn = r + NGW;
        if (rn < MALL) PREP1_LOAD(rn, nq0, nq1, nk0, nk1);
        const bool isctx = r >= MLAT; const int rc = isctx ? r - MLAT : r;
        const int b = isctx ? (rc >> 8) : (rc >> 13), t = isctx ? (rc & 255) : (rc & 8191);
        float cs[16], sn[16];
        if (!isctx) {
            rope_cs<16, 32>(tab, hl0, t, cs, sn);
            float x[16]; unpack8(q0, x); unpack8(q1, x + 8);
            float ss = 0.f;
#pragma unroll
            for (int e = 0; e < 16; ++e) ss += x[e] * x[e];
            ss += __shfl_xor(ss, 1); ss += __shfl_xor(ss, 2); ss += __shfl_xor(ss, 4);
            const float rms = rsqrtf(ss * (1.f / 128.f) + EPS);
#pragma unroll
            for (int e = 0; e < 16; ++e) x[e] = x[e] * rms * qn[e];
            rope_apply<16, 32>(x, hl0, cs, sn);
            *(u32x4_t*)(QC + (size_t)r * DM + 16 * lane) = pack8(x); *(u32x4_t*)(QC + (size_t)r * DM + 16 * lane + 8) = pack8(x + 8);
        }
        {
            float x[16]; unpack8(k0, x); unpack8(k1, x + 8);
            float ss = 0.f;
#pragma unroll
            for (int e = 0; e < 16; ++e) ss += x[e] * x[e];
            ss += __shfl_xor(ss, 1); ss += __shfl_xor(ss, 2); ss += __shfl_xor(ss, 4);
            const float rms = rsqrtf(ss * (1.f / 128.f) + EPS);
#pragma unroll
            for (int e = 0; e < 16; ++e) x[e] = x[e] * rms * kn[e];
            if (!isctx) rope_apply<16, 32>(x, hl0, cs, sn);
            const size_t dst = ((size_t)b * TALL + (isctx ? t : CTXL + t)) * 256;
            if (lane < 16) { *(u32x4_t*)(KC + dst + 16 * lane) = pack8(x); *(u32x4_t*)(KC + dst + 16 * lane + 8) = pack8(x + 8); }
            else if (lane < 32) { *(u32x4_t*)(VC + dst + 16 * (lane - 16)) = k0; *(u32x4_t*)(VC + dst + 16 * (lane - 16) + 8) = k1; }
        }
        q0 = nq0; q1 = nq1; k0 = nk0; k1 = nk1;
    }
#undef PREP1_LOAD
}

#ifndef STOP_PHASE
#define STOP_PHASE 99
#endif
#ifndef PROBE
#define PROBE 0
#endif
#ifndef MOE_GATHER_FUSED
#define MOE_GATHER_FUSED 1
#endif
#ifndef BG_ON
#define BG_ON 1
#endif
constexpr int BG_S1_N = 3, BG_S2_N = 0, BG_S3_N = 5, BG_S4_N = 8, BG_S0_N = 4, BG_S5_N = 4, BG_S6_N = 8;
constexpr int BG_S1_BASE = 0, BG_S2_BASE = BG_S1_BASE + BG_S1_N * (256 - 16 * SCAN_NSPLIT), BG_S3_BASE = BG_S2_BASE + BG_S2_N * 256, BG_S4_BASE = BG_S3_BASE + BG_S3_N * 192;
constexpr int BG_S0_BASE = BG_S4_BASE + BG_S4_N * 116, BG_S5_BASE = BG_S0_BASE + BG_S0_N * 224;
constexpr int BG_S6_BASE = BG_S5_BASE + BG_S5_N * 224;
constexpr int BG_END = BG_S6_BASE + BG_S6_N * 42;
#define REP(k) for (int rep_ = 0; rep_ < ((PROBE == (k)) ? 2 : 1); ++rep_)
__device__ __forceinline__ void copy_out(const Params& p, const float* src) {
    const size_t n4 = (size_t)MLAT * DM / 4;
    for (size_t i = (size_t)blockIdx.x * NTHREADS + opaque_tid(); i < n4; i += (size_t)gridDim.x * NTHREADS) ((f32x4_t*)p.out)[i] = ((const f32x4_t*)src)[i];
}
#define GSYNC() xcd_barrier(xbar)
__device__ __forceinline__ void moe_block(const Params& p, LAS unsigned char* lds, const XcdBarrier& xbar, int layer, bool with_ctx) {
    unsigned char* ws = launder(p.ws); const int G = gridDim.x, bid = blockIdx.x;
    const bf16_raw* W1 = (const bf16_raw*)(ws + WS_W1) + (size_t)layer * NEXP * 4096 * 1024;
    const bf16_raw* W2 = (const bf16_raw*)(ws + WS_W2) + (size_t)layer * NEXP * 1024 * 2048;
    bf16_raw* XG = (bf16_raw*)(ws + WS_XG); bf16_raw* HID = (bf16_raw*)(ws + WS_HID); bf16_raw* YE = (bf16_raw*)(ws + WS_YE);
    const int nMt = with_ctx ? 9 : 8;
    phase_select(p, lds, with_ctx);
    if (BG_ON && with_ctx && bid >= 64) tr_items(p, lds, 1, BG_S3_BASE + (bid - 64), G - 64, BG_S3_N);
    if (BG_ON && !with_ctx && bid >= 32) tr_items(p, lds, 1, BG_S5_BASE + (bid - 32), G - 32, BG_S5_N);
    GSYNC();
#if MOE_GATHER_FUSED
    { pg8::Gemm g{(const bf16_raw*)(ws + WS_H2), W1, NEXP * EROWS, NEXP * 4096, 1024, (const int*)(ws + WS_IDX)}; pg8::MoeOrder S; S.init(nMt, 16, G, bid); pg8::EpiSwiglu E{HID};
      pg8::gemm_phase<pg8::EpiSwiglu, pg8::MoeOrder, true, true, true>(lds, g, S, E); }
#else
    phase_gather(p, with_ctx ? EROWS : 2 * CAPL); GSYNC();
    { pg8::Gemm g{XG, W1, NEXP * EROWS, NEXP * 4096, 1024}; pg8::MoeOrder S; S.init(nMt, 16, G, bid); pg8::EpiSwiglu E{HID};
      pg8::gemm_phase<pg8::EpiSwiglu, pg8::MoeOrder, true, true>(lds, g, S, E); }
#endif
    GSYNC();
    { pg8::Gemm g{HID, W2, NEXP * EROWS, NEXP * 1024, 2048}; pg8::MoeOrder S; S.init(8, 4, G, bid); pg8::EpiDown E{YE, (const float*)(ws + WS_GATE)};
      pg8::gemm_phase<pg8::EpiDown, pg8::MoeOrder, true, true>(lds, g, S, E);
      if (with_ctx) for (int t = bid; t < NEXP * 32; t += G) { const int e = t >> 5;
          moe2_ctx_piece(HID + (size_t)e * EROWS * FF, W2 + (size_t)e * 1024 * 2048, (const float*)(ws + WS_GATE) + e * EROWS, YE + (size_t)e * EROWS * DM, t & 31); } }
    GSYNC();
}

__global__ void __launch_bounds__(NTHREADS, 2) mega(Params p) {
    extern __shared__ __attribute__((aligned(16))) unsigned char lds_raw[];
    LAS unsigned char* lds = (LAS unsigned char*)lds_raw;
    __builtin_assume(__builtin_amdgcn_workitem_id_y() == 0); __builtin_assume(__builtin_amdgcn_workitem_id_z() == 0);
    cg::grid_group grid = cg::this_grid();
    const int G = gridDim.x, bid = blockIdx.x;
    volatile LAS unsigned* xst = (volatile LAS unsigned*)(lds + LDS_BYTES - 16);
    if (opaque_tid() < 4) xst[opaque_tid()] = 0u;
    __syncthreads();
    const XcdBarrier xbar = xcd_barrier_post((unsigned*)launder(p.ws) + WS_CTL / 4, xst);
    unsigned char* ws = launder(p.ws);
    float* MOD = (float*)(ws + WS_MOD);
    bf16_raw* H = (bf16_raw*)(ws + WS_H); bf16_raw* H2 = (bf16_raw*)(ws + WS_H2);
    float* XA = (float*)(ws + WS_XA); float* XB = (float*)(ws + WS_XB);
    bf16_raw* P = (bf16_raw*)(ws + WS_P); bf16_raw* OAB = (bf16_raw*)(ws + WS_OAB);
    float* AFF = (float*)(ws + WS_AFF);

    if (p.ws == nullptr) grid.sync();
    REP(1) { phase_prep_weights(p, lds, BG_ON ? BG_END : 0); GSYNC(); }
    if (PROBE == 21) { phase_prep_weights(p, lds, -1); GSYNC(); }
    if (PROBE == 2) { for (int k = 0; k < 20; ++k) GSYNC(); }
    if (PROBE == 8) {
        const f32x4_t* src = (const f32x4_t*)p.in[I_WG]; u32x2_t* dst = (u32x2_t*)(ws + WS_HID);
        const size_t n4 = (size_t)2 * 16 * 1024 * 2048 / 4;
        for (size_t i = (size_t)bid * NTHREADS + opaque_tid(); i < n4; i += (size_t)G * NTHREADS) { const f32x4_t v = src[i]; u32x2_t w; w.x = pk2(v.x, v.y); w.y = pk2(v.z, v.w); dst[i] = w; }
        GSYNC();
    }
    REP(10) { phase_norm<1>(p.in[I_X], p.in[I_CTX], MALL, p.in[I_NMIX], MOD, H, p.in[I_WINAB] + NAB, LDW_AB, (float*)(ws + WS_AB), lds); GSYNC(); }
    REP(11) { { pg8::Gemm g{H, (const bf16_raw*)(ws + WS_WINAB), MALL, NAB, 1024}; pg8::StaticOrder S; S.init(MALL, NAB, G, bid); pg8::EpiBf16<0> E{P, NAB, nullptr, 0, 0, 1.f};
      pg8::gemm_phase<pg8::EpiBf16<0>, pg8::StaticOrder, true, true>(lds, g, S, E);
      if (BG_ON && bid >= 214) tr_items(p, lds, 1, BG_S6_BASE + (bid - 214), G - 214, BG_S6_N); }
    GSYNC(); }
    REP(7) { phase_bprep(p, lds); if (bid >= 32) { phase_prep0(p, bid - 32, G - 32); if (BG_ON) tr_items(p, lds, 1, BG_S0_BASE + (bid - 32), G - 32, BG_S0_N); } GSYNC(); }
    {
        if (bid < 16 * SCAN_NSPLIT) scan_chain<0>(p, lds, bid / SCAN_NSPLIT, bid % SCAN_NSPLIT);
        unsigned* qctr = (unsigned*)(ws + WS_CTL) + 4000;
        volatile LAS int* qslot = (volatile LAS int*)(lds + LDS_BYTES - 32);
        for (;;) {
            __syncthreads();
            if (opaque_tid() == 0) qslot[0] = (int)__hip_atomic_fetch_add(qctr, 1u, __ATOMIC_RELAXED, __HIP_MEMORY_SCOPE_AGENT);
            __syncthreads();
            const int u = qslot[0];
            if (u >= 528) break;
            if (u < 512) { const int b = u >> 8, kvh = (u >> 7) & 1, qb = u & 127; attnA_unit(p, lds, b, kvh, b * SEQ + qb * 64, qb * 64, true); }
            else { const int uc = u - 512, b = uc >> 3, kvh = (uc >> 2) & 1, qb = uc & 3; attnA_unit(p, lds, b, kvh, MLAT + b * CTXL + qb * 64, qb * 64, false); }
        }
        if (BG_ON && bid >= 16 * SCAN_NSPLIT) tr_items(p, lds, 1, BG_S1_BASE + (bid - 16 * SCAN_NSPLIT), G - 16 * SCAN_NSPLIT, BG_S1_N);
    }
    GSYNC();
    REP(12) { phase_outgate(p, lds); GSYNC(); }
    REP(13) { { pg8::Gemm g{OAB, (const bf16_raw*)(ws + WS_WOUTAB), MLAT, 1024, 1024}; pg8::StaticOrder S; S.init(MLAT, 1024, G, bid); pg8::EpiResid E{p.in[I_X], p.in[I_CTX], XA, MOD + 2048};
      pg8::gemm_phase<pg8::EpiResid, pg8::StaticOrder, true, true>(lds, g, S, E);
      for (int t = bid; t < 256; t += G) mini_resid_tile(OAB + (size_t)MLAT * DM, (const bf16_raw*)(ws + WS_WOUTAB), p.in[I_CTX], MOD + 2048 + 2 * 6144, XA + (size_t)MLAT * DM, (t >> 5) * 64, (t & 31) * 32);
      if (BG_ON) tr_items(p, lds, 1, BG_S2_BASE + bid, G, BG_S2_N); }
    GSYNC(); }
    if (STOP_PHASE == 6) { copy_out(p, XA); return; }
    REP(14) { phase_norm<2>(XA, XA + (size_t)MLAT * DM, MALL, p.in[I_NFFN], MOD + 3072, H2, p.in[I_WR], 16, AFF, lds); GSYNC(); }
    moe_block(p, lds, xbar, 0, true);
    REP(15) { phase_combine<false>(p, 0); GSYNC(); }
    if (STOP_PHASE == 12) { copy_out(p, XB); return; }
    REP(16) { { pg8::Gemm g{H, (const bf16_raw*)(ws + WS_WINC), MALL, NC, 1024}; pg8::StaticOrder S; S.init(MALL, NC, G, bid); pg8::EpiBf16<0> E{P, NC, nullptr, 0, 0, 1.f};
      pg8::gemm_phase<pg8::EpiBf16<0>, pg8::StaticOrder, true, true>(lds, g, S, E);
      if (BG_ON && bid >= 140) tr_items(p, lds, 1, BG_S4_BASE + (bid - 140), G - 140, BG_S4_N); }
    GSYNC(); }
    REP(17) { phase_prep1(p); GSYNC(); }
    REP(6) {
        const attc::bf16* QC = (const attc::bf16*)(ws + WS_QA); const attc::bf16* KC = (const attc::bf16*)(ws + WS_KA); const attc::bf16* VC = (const attc::bf16*)(ws + WS_VA);
        for (int u = bid; u < 512; u += G) {
            const int qblk = u & 31, hh = (u >> 5) & 7, b = u >> 8;
            const size_t qoff = ((size_t)(b * SEQ + qblk * 256) * 8 + hh) * 128, koff = ((size_t)b * TALL * 2 + (hh >> 2)) * 128;
            int seq = TALL; asm volatile("" : "+s"(seq));
            attc::attn_dense_body<attc::bf16>(launder(QC + qoff), launder(KC + koff), launder(VC + koff), launder(OAB + qoff), seq, (char*)lds_raw);
            __syncthreads();
        }
    }
    GSYNC();
    REP(18) { { pg8::Gemm g{OAB, (const bf16_raw*)(ws + WS_WOUTC), MLAT, 1024, 1024}; pg8::StaticOrder S; S.init(MLAT, 1024, G, bid); pg8::EpiResid E{XB, XB + (size_t)MLAT * DM, XA, MOD + 3 * 6144 + 2048};
      pg8::gemm_phase<pg8::EpiResid, pg8::StaticOrder, true, true>(lds, g, S, E); }
    GSYNC(); }
    if (STOP_PHASE == 16) { copy_out(p, XA); return; }
    phase_norm<2>(XA, XA + (size_t)MLAT * DM, MLAT, p.in[I_NFFN] + 1024, MOD + 3 * 6144 + 3072, H2, p.in[I_WR] + 1024 * 16, 16, AFF, lds); GSYNC();
    REP(5) moe_block(p, lds, xbar, 1, false);
    phase_combine<true>(p, 1);
}

extern "C" void kernel_launch(void* const* d_in, const int* in_sizes, int n_in, void* d_out, int out_size, void* d_ws, size_t ws_size, hipStream_t stream) {
    static int grid_blocks = 0;
    if (grid_blocks == 0) {
        int dev = 0, cus = 0, per_cu = 0;
        if (n_in != 25 || out_size != MLAT * DM || ws_size < WS_END) { fprintf(stderr, "kernel_launch: unexpected shapes: n_in %d out %d ws %zu (need %zu)\n", n_in, out_size, ws_size, (size_t)WS_END); grid_blocks = -1; return; }
        (void)hipGetDevice(&dev);
        (void)hipDeviceGetAttribute(&cus, hipDeviceAttributeMultiprocessorCount, dev);
        if (hipFuncSetAttribute((const void*)mega, hipFuncAttributeMaxDynamicSharedMemorySize, LDS_BYTES) != hipSuccess) { fprintf(stderr, "hipFuncSetAttribute failed\n"); grid_blocks = -1; return; }
        (void)hipOccupancyMaxActiveBlocksPerMultiprocessor(&per_cu, (const void*)mega, NTHREADS, LDS_BYTES);
        if (per_cu < 1) { fprintf(stderr, "kernel_launch: occupancy query says 0 blocks per CU\n"); grid_blocks = -1; return; }
        if (cus != 256) { fprintf(stderr, "kernel_launch: built for a 256-CU device (static work split), found %d CUs; nothing launched\n", cus); grid_blocks = -1; return; }
        grid_blocks = cus;
    }
    if (grid_blocks < 0) return;
    if (hipMemsetAsync((char*)d_ws + WS_CTL, 0, CTL_BYTES, stream) != hipSuccess) { fprintf(stderr, "kernel_launch: hipMemsetAsync failed\n"); return; }
    Params p{};
    for (int i = 0; i < 25; ++i) p.in[i] = (const float*)d_in[i];
    p.out = (float*)d_out; p.ws = (unsigned char*)d_ws;
    void* args[] = {&p};
    hipError_t e = hipLaunchCooperativeKernel((const void*)mega, dim3(grid_blocks), dim3(NTHREADS), args, LDS_BYTES, stream);
    if (e != hipSuccess) fprintf(stderr, "cooperative launch failed: %s (grid %d)\n", hipGetErrorString(e), grid_blocks);
}
```

```cpp
#include <hip/hip_runtime.h>
#include <hip/hip_bf16.h>
#include <hip/hip_cooperative_groups.h>
#include <cstdio>
#include <cstdint>
namespace cg = cooperative_groups;
#ifndef PROBE
#define PROBE 0
#endif

constexpr int NTHREADS = 512, NWAVES = 8;
constexpr int LDS_BYTES = 147456;
constexpr int BATCH = 2, SEQ = 8192, CTXL = 256, DM = 1024;
constexpr int MLAT = BATCH * SEQ, MCTX = BATCH * CTXL, MALL = MLAT + MCTX;
constexpr int TALL = CTXL + SEQ;
constexpr int NAB = 2816, LDW_AB = 2832;
constexpr int NC = 1536;
constexpr int NEXP = 16, FF = 2048, CAPL = 1024, CAPC = 32, EROWS = 2304;
constexpr float EPS = 1e-6f;

constexpr size_t al256(size_t x) { return (x + 255) / 256 * 256; }
constexpr size_t WS_CTL   = 0;
constexpr size_t CTL_BYTES = 16384;
constexpr size_t WS_MOD   = CTL_BYTES;
constexpr size_t WS_ROPE  = al256(WS_MOD + (size_t)2 * 3 * 6144 * 4);
constexpr size_t WS_AB    = al256(WS_ROPE + (size_t)6144 * 8);
constexpr size_t WS_AFF   = al256(WS_AB + (size_t)MALL * 16 * 4);
constexpr size_t WS_IDX   = al256(WS_AFF + (size_t)2 * 16 * (SEQ + CTXL) * 4);
constexpr size_t WS_GATE  = al256(WS_IDX + (size_t)NEXP * EROWS * 4);
constexpr size_t WS_INV   = al256(WS_GATE + (size_t)NEXP * EROWS * 4);
constexpr size_t WS_WINAB = al256(WS_INV + (size_t)MALL * 16 * 4);
constexpr size_t WS_WOUTAB= al256(WS_WINAB + (size_t)NAB * DM * 2);
constexpr size_t WS_WINC  = al256(WS_WOUTAB + (size_t)DM * DM * 2);
constexpr size_t WS_WOUTC = al256(WS_WINC + (size_t)NC * DM * 2);
constexpr size_t WS_W1    = al256(WS_WOUTC + (size_t)DM * DM * 2);
constexpr size_t WS_W2    = al256(WS_W1 + (size_t)2 * NEXP * 4096 * DM * 2);
constexpr size_t WS_H     = al256(WS_W2 + (size_t)2 * NEXP * DM * FF * 2);
constexpr size_t WS_XA    = al256(WS_H + (size_t)MALL * DM * 2);
constexpr size_t WS_XB    = al256(WS_XA + (size_t)MALL * DM * 4);
constexpr size_t WS_R     = al256(WS_XB + (size_t)MALL * DM * 4);
constexpr int NCHUNK = 132;
constexpr size_t BLOB = 73984;
constexpr int BL_WN = 0, BL_QG = 16384, BL_AQK = 32768, BL_KDT = 40960, BL_U = 57344, BL_GE = 73728;
constexpr size_t WS_P     = WS_R;
constexpr size_t WS_QA    = al256(WS_P + (size_t)MALL * NAB * 2);
constexpr size_t WS_KA    = al256(WS_QA + (size_t)MLAT * DM * 2);
constexpr size_t WS_VA    = al256(WS_KA + (size_t)BATCH * TALL * 256 * 2);
constexpr size_t WS_BLOB  = al256(WS_VA + (size_t)BATCH * TALL * 256 * 2);
constexpr size_t SNAP = 49152;
constexpr size_t WS_SNAP  = al256(WS_BLOB + (size_t)16 * NCHUNK * BLOB);
constexpr size_t WS_OAB   = al256(WS_SNAP + (size_t)16 * NCHUNK * SNAP);
constexpr size_t WS_MIX_END = al256(WS_OAB + (size_t)MALL * DM * 2);
constexpr size_t WS_XG    = WS_R;
constexpr size_t WS_HID   = al256(WS_XG + (size_t)NEXP * EROWS * DM * 2);
constexpr size_t WS_YE    = al256(WS_HID + (size_t)NEXP * EROWS * FF * 2);
constexpr size_t WS_H2    = al256(WS_YE + (size_t)NEXP * EROWS * DM * 2);
constexpr size_t WS_MOE_END = al256(WS_H2 + (size_t)MALL * DM * 2);
constexpr size_t WS_END   = WS_MIX_END > WS_MOE_END ? WS_MIX_END : WS_MOE_END;
static_assert(WS_END <= (size_t)1024 * 1024 * 1024, "workspace map must fit 1 GiB");

#define LAS __attribute__((address_space(3)))
typedef unsigned short bf16_raw;
typedef unsigned u32x4_t __attribute__((ext_vector_type(4)));
typedef unsigned u32x2_t __attribute__((ext_vector_type(2)));
typedef float f32x4_t __attribute__((ext_vector_type(4)));
typedef float f32x2_t __attribute__((ext_vector_type(2)));
template <class T> __device__ __forceinline__ T* launder(T* p) { size_t z = 0; asm volatile("" : "+s"(z)); return (T*)((char*)p + z); }
__device__ __forceinline__ int opaque_tid() { int t = threadIdx.x; asm volatile("" : "+v"(t)); return t; }
__device__ __forceinline__ float bf2f(unsigned u) { return __uint_as_float(u << 16); }
__device__ __forceinline__ unsigned short f2bf_rne(float f) { unsigned u = __float_as_uint(f); return (unsigned short)((u + 0x7fffu + ((u >> 16) & 1u)) >> 16); }
typedef float cvt_f32x2_t __attribute__((ext_vector_type(2)));
typedef __bf16 cvt_bf16x2_t __attribute__((ext_vector_type(2)));
__device__ __forceinline__ unsigned cvtpk_a(float lo, float hi) { const cvt_f32x2_t v = {lo, hi}; const cvt_bf16x2_t b = __builtin_convertvector(v, cvt_bf16x2_t); return __builtin_bit_cast(unsigned, b); }
__device__ __forceinline__ unsigned pk2(float lo, float hi) { return cvtpk_a(lo, hi); }
__device__ __forceinline__ float wave_sum(float v) {
#pragma unroll
    for (int o = 1; o < 64; o <<= 1) v += __shfl_xor(v, o);
    return v;
}
__device__ __forceinline__ float silu_f(float x) { return x * __builtin_amdgcn_rcpf(1.f + __expf(-x)); }
__device__ __forceinline__ void unpack8(u32x4_t w, float* x) {
    x[0] = bf2f(w.x & 0xffffu); x[1] = bf2f(w.x >> 16); x[2] = bf2f(w.y & 0xffffu); x[3] = bf2f(w.y >> 16);
    x[4] = bf2f(w.z & 0xffffu); x[5] = bf2f(w.z >> 16); x[6] = bf2f(w.w & 0xffffu); x[7] = bf2f(w.w >> 16);
}
__device__ __forceinline__ u32x4_t pack8(const float* x) { u32x4_t w; w.x = pk2(x[0], x[1]); w.y = pk2(x[2], x[3]); w.z = pk2(x[4], x[5]); w.w = pk2(x[6], x[7]); return w; }

namespace pg8 {
#define PG8_LAS __attribute__((address_space(3)))
typedef unsigned short bf16_t;
typedef short bf16x8 __attribute__((ext_vector_type(8)));
typedef float f32x4 __attribute__((ext_vector_type(4)));
typedef unsigned u32x4 __attribute__((ext_vector_type(4)));
constexpr int BM = 256, BK = 64, HALF = 128, HTB = HALF * BK * 2  , STAGE_BYTES = 8 * HTB, NXCD = 8, WGM = 8;

__host__ __device__ __forceinline__ int lds_byte(int r, int c) { const int st = (r >> 4) * 2 + (c >> 5), rr = r & 15, cc = c & 31, ob = rr * 64 + cc * 2; return st * 1024 + (ob ^ (((ob >> 9) & 1) << 5)); }
__host__ __device__ __forceinline__ void stage_rc(int b, int& R, int& C) { const int st = b / 1024, sb = b % 1024, swz = sb ^ (((sb >> 9) & 1) << 5); R = (st >> 1) * 16 + swz / 64; C = (st & 1) * 32 + (swz % 64) / 2; }
__host__ __device__ __forceinline__ int perm32(int rho) { const int n = rho >> 4, i = rho & 15; return 8 * (i >> 2) + 4 * n + (i & 3); }

struct Unit { int pm, pn; };
struct Gemm { const bf16_t* A; const bf16_t* Bt; int M, N, K; const int* gidx = nullptr; };

struct StaticOrder {
    int nM, nN, nwg, G, c;
    __host__ __device__ void init(int M, int N, int G_, int c_) { nM = M / BM; nN = N / BM; nwg = nM * nN; G = G_; c = c_; }
    __host__ __device__ bool next(int i, Unit& u) const {
        const long L = (long)i * G + c; if (L >= nwg) return false;
        int wgid = (int)L; { const int q = nwg / NXCD, r = nwg % NXCD, xcd = wgid % NXCD, off = wgid / NXCD; wgid = (xcd < r ? xcd * (q + 1) : r * (q + 1) + (xcd - r) * q) + off; }
        const int nig = WGM * nN, gid = wgid / nig, fm = gid * WGM, gsz = (nM - fm) < WGM ? (nM - fm) : WGM;
        u.pm = fm + ((wgid % nig) % gsz); u.pn = (wgid % nig) / gsz; return true;
    }
    __device__ __forceinline__ void a_ready(const Unit&) const {}
    __device__ __forceinline__ void done(const Unit&) const {}
};

__device__ __forceinline__ unsigned cvt_pk_bf16(float lo, float hi) { unsigned r; asm volatile("v_cvt_pk_bf16_f32 %0, %1, %2" : "=v"(r) : "v"(lo), "v"(hi)); return r; }
typedef float f32x2 __attribute__((ext_vector_type(2)));
__device__ __forceinline__ f32x2 gelu_pk(f32x2 v) {
    const f32x2 av = __builtin_elementwise_abs(v), d = av * 0.2316418882f + 1.0f;
    f32x2 t; t.x = __builtin_amdgcn_rcpf(d.x); t.y = __builtin_amdgcn_rcpf(d.y);
    f32x2 q = t * 0.5307027145f + (-0.7265760135f); q = q * t + 0.7107068705f; q = q * t + (-0.142248368f); q = q * t + 0.127414796f; q = q * t;
    const f32x2 s = (v * v) * (-0.72134752044f);
    f32x2 e; e.x = __builtin_amdgcn_exp2f(s.x); e.y = __builtin_amdgcn_exp2f(s.y);
    const f32x2 m = v * (q * e), r = v - m;
    f32x2 o; o.x = v.x < 0.f ? m.x : r.x; o.y = v.y < 0.f ? m.y : r.y; return o;
}

template <int ACT  > struct EpiBf16 {
    static constexpr bool PERM = true, AFTER_DRAIN = false; static_assert(ACT == 0 || ACT == 1, "EpiBf16: ACT is 0 (none) or 1 (gelu_pk)");
    bf16_t* O; int ldc; const float* bias; int split_cols; size_t split_stride; float scale0;
    __device__ __forceinline__ void operator()(const f32x4 (&acc)[2][2][4][2], const Unit& u, int wr, int wc, int fr, int fq) const {
        const int row0 = u.pm * BM + wr * 64 + fr; int colt = u.pn * BM; bf16_t* base = O;
        float sc = 1.f; if (split_cols) { const int t = colt / split_cols; base += (size_t)t * split_stride; colt -= t * split_cols; if (t == 0) sc = scale0; }
        const int col0 = colt + wc * 32 + 8 * fq, bcol0 = u.pn * BM + wc * 32 + 8 * fq;
        f32x4 bv[2][2];
#pragma unroll
        for (int bj = 0; bj < 2; ++bj)
#pragma unroll
            for (int n = 0; n < 2; ++n) bv[bj][n] = bias ? *(const f32x4*)(bias + bcol0 + bj * HALF + 4 * n) : (f32x4){0.f, 0.f, 0.f, 0.f};
#pragma unroll
        for (int ai = 0; ai < 2; ++ai)
#pragma unroll
            for (int m = 0; m < 4; ++m) { bf16_t* rowp = base + (size_t)(row0 + ai * HALF + m * 16) * ldc + col0;
#pragma unroll
                for (int bj = 0; bj < 2; ++bj) { f32x4 v0 = acc[ai][bj][m][0] + bv[bj][0], v1 = acc[ai][bj][m][1] + bv[bj][1];
                    if (ACT == 1) { f32x2 a = gelu_pk((f32x2){v0[0], v0[1]}), b = gelu_pk((f32x2){v0[2], v0[3]}), c = gelu_pk((f32x2){v1[0], v1[1]}), d = gelu_pk((f32x2){v1[2], v1[3]});
                        v0 = (f32x4){a.x, a.y, b.x, b.y}; v1 = (f32x4){c.x, c.y, d.x, d.y}; }
                    v0 = v0 * sc; v1 = v1 * sc; u32x4 w; w.x = cvt_pk_bf16(v0[0], v0[1]); w.y = cvt_pk_bf16(v0[2], v0[3]); w.z = cvt_pk_bf16(v1[0], v1[1]); w.w = cvt_pk_bf16(v1[2], v1[3]);
                    *(u32x4*)(rowp + bj * HALF) = w; } }
    }
};

struct EpiResid {
    static constexpr bool PERM = false, AFTER_DRAIN = false;
    const float* res_lat; const float* res_ctx; float* out; const float* gate3;
    __device__ __forceinline__ void operator()(const f32x4 (&acc)[2][2][4][2], const Unit& u, int wr, int wc, int fr, int fq) const {
        const int rowt = u.pm * BM;
        const float* res = (rowt < MLAT) ? res_lat + (size_t)rowt * DM : res_ctx + (size_t)(rowt - MLAT) * DM;
        const int v = (rowt < MLAT) ? (rowt >> 13) : 2;
        const float* gate = gate3 + v * 6144;
        const int col0 = u.pn * BM + wc * 32 + 4 * fq;
        f32x4 gv[2][2];
#pragma unroll
        for (int bj = 0; bj < 2; ++bj)
#pragma unroll
            for (int n = 0; n < 2; ++n) gv[bj][n] = *(const f32x4*)(gate + col0 + bj * HALF + n * 16);
#pragma unroll
        for (int ai = 0; ai < 2; ++ai)
#pragma unroll
            for (int m = 0; m < 4; ++m) {
                const int row = wr * 64 + fr + ai * HALF + m * 16;
#pragma unroll
                for (int bj = 0; bj < 2; ++bj)
#pragma unroll
                    for (int n = 0; n < 2; ++n) {
                        const int c = col0 + bj * HALF + n * 16;
                        const f32x4 r4 = *(const f32x4*)(res + (size_t)row * DM + c);
                        *(f32x4*)(out + (size_t)(rowt + row) * DM + c) = r4 + gv[bj][n] * acc[ai][bj][m][n];
                    }
            }
    }
};
__device__ __forceinline__ float silu_fast(float g) { return g * __builtin_amdgcn_rcpf(1.f + __expf(-g)); }
struct EpiSwiglu {
    static constexpr bool PERM = true, AFTER_DRAIN = false;
    bf16_t* HID;
    __device__ __forceinline__ void operator()(const f32x4 (&acc)[2][2][4][2], const Unit& u, int wr, int wc, int fr, int fq) const {
        const int row0 = u.pm * BM + wr * 64 + fr, colbase = (u.pn & 15) * 128 + wc * 32 + 8 * fq;
#pragma unroll
        for (int ai = 0; ai < 2; ++ai)
#pragma unroll
            for (int m = 0; m < 4; ++m) {
                bf16_t* rowp = HID + (size_t)(row0 + ai * HALF + m * 16) * FF + colbase;
                const f32x4 g0 = acc[ai][0][m][0], g1 = acc[ai][0][m][1], u0 = acc[ai][1][m][0], u1 = acc[ai][1][m][1];
                u32x4 w;
                w.x = cvt_pk_bf16(silu_fast(g0[0]) * u0[0], silu_fast(g0[1]) * u0[1]); w.y = cvt_pk_bf16(silu_fast(g0[2]) * u0[2], silu_fast(g0[3]) * u0[3]);
                w.z = cvt_pk_bf16(silu_fast(g1[0]) * u1[0], silu_fast(g1[1]) * u1[1]); w.w = cvt_pk_bf16(silu_fast(g1[2]) * u1[2], silu_fast(g1[3]) * u1[3]);
                *(u32x4*)rowp = w;
            }
    }
};
struct EpiDown {
    static constexpr bool PERM = true, AFTER_DRAIN = false;
    bf16_t* YE; const float* gate;
    __device__ __forceinline__ void operator()(const f32x4 (&acc)[2][2][4][2], const Unit& u, int wr, int wc, int fr, int fq) const {
        const int row0 = u.pm * BM + wr * 64 + fr, colbase = (u.pn & 3) * 256 + wc * 32 + 8 * fq;
#pragma unroll
        for (int ai = 0; ai < 2; ++ai)
#pragma unroll
            for (int m = 0; m < 4; ++m) {
                const int row = row0 + ai * HALF + m * 16; const float gr = gate[row];
                bf16_t* rowp = YE + (size_t)row * DM + colbase;
#pragma unroll
                for (int bj = 0; bj < 2; ++bj) {
                    const f32x4 v0 = acc[ai][bj][m][0] * gr, v1 = acc[ai][bj][m][1] * gr;
                    u32x4 w; w.x = cvt_pk_bf16(v0[0], v0[1]); w.y = cvt_pk_bf16(v0[2], v0[3]); w.z = cvt_pk_bf16(v1[0], v1[1]); w.w = cvt_pk_bf16(v1[2], v1[3]);
                    *(u32x4*)(rowp + bj * HALF) = w;
                }
            }
    }
};
struct MoeOrder {
    int nMt, nNt, G, c, total;
    __device__ void init(int nMt_, int nNt_, int G_, int c_) { nMt = nMt_; nNt = nNt_; G = G_; c = c_; total = NEXP * nMt * nNt; }
    __device__ bool next(int i, Unit& u) const {
        if (nNt == 4 && nMt == 8 && G == 256) {
            const int x = c & 7, k = c >> 3, e = i * 8 + (x >> 1) * 2 + (k >> 4), kk = k & 15; if (e >= NEXP) return false;
            u.pm = e * 9 + (x & 1) * 4 + (kk & 3); u.pn = e * 4 + (kk >> 2); return true;
        }
        const int L = i * G + c; if (L >= total) return false;
        const int per = nMt * nNt, e = L / per, rem = L % per;
        int pnl, pml;
        if (nNt == 16) { const int j = rem & 7, t = rem >> 3; pml = t >> 1; pnl = j + 8 * (t & 1); }
        else { pnl = rem / nMt; pml = rem % nMt; }
        u.pm = e * 9 + pml; u.pn = e * nNt + pnl; return true;
    }
    __device__ __forceinline__ void a_ready(const Unit&) const {}
    __device__ __forceinline__ void done(const Unit&) const {}
};
template <class Epi, class Sched, bool ALIGN_EPI = false, bool SP2 = false, bool GATHER = false>
__device__ __forceinline__ void gemm_phase(PG8_LAS unsigned char* lds, const Gemm g, const Sched& S, const Epi& E) {
    const int tid = opaque_tid(), wid = __builtin_amdgcn_readfirstlane(tid >> 6), lane = tid & 63, wr = wid >> 2, wc = wid & 3, fr = lane & 15, fq = lane >> 4;
    const int K = g.K, nt = K / BK;
    unsigned voffA[2], voffB[2];
#pragma unroll
    for (int i = 0; i < 2; ++i) { int R, C; stage_rc(tid * 16 + i * 8192, R, C); const int Rb = Epi::PERM ? ((R & ~31) + perm32(R & 31)) : R;
        voffA[i] = (unsigned)(R * K + C) * 2u; voffB[i] = (unsigned)(Rb * K + C) * 2u; }
    static_assert(!GATHER || SP2, "GATHER is wired into the SP2 loop only");
    unsigned gcur[2][2] = {{0u, 0u}, {0u, 0u}}, gnxt[2][2] = {{0u, 0u}, {0u, 0u}};
#define PG8_GIDX(U, GO) do { _Pragma("unroll") for (int h_ = 0; h_ < 2; ++h_) _Pragma("unroll") for (int i_ = 0; i_ < 2; ++i_) { int R_, C_; stage_rc(tid * 16 + i_ * 8192, R_, C_); \
        int r_ = g.gidx[(size_t)(U).pm * BM + h_ * HALF + R_]; r_ = r_ < 0 ? 0 : r_; GO[h_][i_] = (unsigned)r_ * (unsigned)(K * 2) + (unsigned)(C_ * 2); } } while (0)
#define PG8_STAGE_G(bufoff, GO, h, kb) do { _Pragma("unroll") for (int _i = 0; _i < 2; ++_i) \
        __builtin_amdgcn_global_load_lds((const unsigned*)((const char*)g.A + (size_t)(GO)[h][_i] + (size_t)(kb)), (PG8_LAS unsigned*)(lds + (bufoff) + ldsw + _i * 8192), 16, 0, 0); } while (0)
    const size_t kstep = (size_t)(BK * 2);
    const size_t hstep = (size_t)HALF * K * 2;
    const size_t tstep = 2 * hstep;
    const unsigned ldsw = (unsigned)wid * 1024u;
    const int aoff = lds_byte(wr * 64 + fr, fq * 8), boff = lds_byte(wc * 32 + fr, fq * 8);
#define PG8_SA(b, h) (((b) * 2 + (h)) * HTB)
#define PG8_SB(b, h) ((4 + (b) * 2 + (h)) * HTB)
#define PG8_STAGE(bufoff, gbase, voff) do { _Pragma("unroll") for (int _i = 0; _i < 2; ++_i) \
        __builtin_amdgcn_global_load_lds((const unsigned*)((const char*)(gbase) + (voff)[_i]), (PG8_LAS unsigned*)(lds + (bufoff) + ldsw + _i * 8192), 16, 0, 0); } while (0)
#define PG8_LDA(dst, b, h) do { _Pragma("unroll") for (int m = 0; m < 4; ++m) _Pragma("unroll") for (int k = 0; k < 2; ++k) dst[m][k] = *(const PG8_LAS bf16x8*)(lds + PG8_SA(b, h) + aoff + m * 2048 + k * 1024); } while (0)
#define PG8_LDB(dst, b, h) do { _Pragma("unroll") for (int n = 0; n < 2; ++n) _Pragma("unroll") for (int k = 0; k < 2; ++k) dst[n][k] = *(const PG8_LAS bf16x8*)(lds + PG8_SB(b, h) + boff + n * 2048 + k * 1024); } while (0)
#define PG8_MMA(ai, bj, At, Bt) do { __builtin_amdgcn_s_setprio(1); _Pragma("unroll") for (int m = 0; m < 4; ++m) _Pragma("unroll") for (int n = 0; n < 2; ++n) _Pragma("unroll") for (int k = 0; k < 2; ++k) \
        acc[ai][bj][m][n] = __builtin_amdgcn_mfma_f32_16x16x32_bf16(Bt[n][k], At[m][k], acc[ai][bj][m][n], 0, 0, 0); __builtin_amdgcn_s_setprio(0); } while (0)
#define PG8_WAIT_V(n) asm volatile("s_waitcnt vmcnt(" #n ")" ::: "memory")
#define PG8_WAIT_L(n) asm volatile("s_waitcnt lgkmcnt(" #n ")" ::: "memory")
#define PG8_BAR __builtin_amdgcn_s_barrier()
#define PG8_SCHED __builtin_amdgcn_sched_barrier(0)
    Unit cur, nxt; int ui = 0;
    if (!S.next(0, cur)) return;
    f32x4 acc[2][2][4][2];
#pragma unroll
    for (int a = 0; a < 2; ++a)
#pragma unroll
        for (int b = 0; b < 2; ++b)
#pragma unroll
            for (int m = 0; m < 4; ++m)
#pragma unroll
                for (int n = 0; n < 2; ++n) acc[a][b][m][n] = (f32x4){0.f, 0.f, 0.f, 0.f};
    bf16x8 At[4][2], B0[2][2], B1[2][2];
    const char* cA = (const char*)g.A + (size_t)cur.pm * tstep; const char* cB = (const char*)g.Bt + (size_t)cur.pn * tstep;
    S.a_ready(cur);
    if constexpr (GATHER) PG8_GIDX(cur, gcur);
    if constexpr (SP2) {
        PG8_STAGE(PG8_SB(0, 0), cB, voffB); PG8_STAGE(PG8_SB(0, 1), cB + hstep, voffB);
        if constexpr (GATHER) { PG8_STAGE_G(PG8_SA(0, 0), gcur, 0, 0); PG8_STAGE_G(PG8_SA(0, 1), gcur, 1, 0); } else { PG8_STAGE(PG8_SA(0, 0), cA, voffA); PG8_STAGE(PG8_SA(0, 1), cA + hstep, voffA); }
        if (wr == 1) PG8_BAR;
        PG8_WAIT_V(2); PG8_BAR;
        PG8_STAGE(PG8_SB(1, 0), cB + kstep, voffB); if constexpr (GATHER) PG8_STAGE_G(PG8_SA(1, 0), gcur, 0, kstep); else PG8_STAGE(PG8_SA(1, 0), cA + kstep, voffA); PG8_STAGE(PG8_SB(1, 1), cB + hstep + kstep, voffB);
        PG8_WAIT_V(6); PG8_BAR;
    } else {
        PG8_STAGE(PG8_SB(0, 0), cB, voffB); PG8_STAGE(PG8_SA(0, 0), cA, voffA); PG8_STAGE(PG8_SB(0, 1), cB + hstep, voffB); PG8_STAGE(PG8_SA(0, 1), cA + hstep, voffA);
        if (wr == 1) PG8_BAR;
        PG8_WAIT_V(4); PG8_BAR;
        PG8_STAGE(PG8_SB(1, 0), cB + kstep, voffB); PG8_STAGE(PG8_SA(1, 0), cA + kstep, voffA); PG8_STAGE(PG8_SB(1, 1), cB + hstep + kstep, voffB);
        PG8_WAIT_V(6); PG8_BAR;
    }
    for (;;) {
        const bool has_next = S.next(ui + 1, nxt);
        if constexpr (GATHER) { if (has_next) PG8_GIDX(nxt, gnxt); }
        const char* nA = has_next ? (const char*)g.A + (size_t)nxt.pm * tstep : cA; const char* nB = has_next ? (const char*)g.Bt + (size_t)nxt.pn * tstep : cB;
        asm volatile(".p2alignl 7, 0xBF800000");
        for (int t = 0; t < nt; t += 2) {
            const bool last = (t == nt - 2);
            const char* a1 = cA + (size_t)(t + 1) * kstep;
            const char* a2 = last ? nA : cA + (size_t)(t + 2) * kstep; const char* b2 = last ? nB : cB + (size_t)(t + 2) * kstep;
            const char* a3 = a2 + kstep; const char* b3 = b2 + kstep;
            if (last && has_next) S.a_ready(nxt);
            unsigned g2[2][2]; size_t k1 = 0, k2 = 0;
            if constexpr (GATHER) {
                const bool usen = last && has_next;
#pragma unroll
                for (int h_ = 0; h_ < 2; ++h_)
#pragma unroll
                    for (int i_ = 0; i_ < 2; ++i_) g2[h_][i_] = usen ? gnxt[h_][i_] : gcur[h_][i_];
                k1 = (size_t)(t + 1) * kstep; k2 = last ? 0 : (size_t)(t + 2) * kstep;
            }
            if constexpr (SP2) {
            PG8_LDB(B0, 0, 0); PG8_LDB(B1, 0, 1); PG8_SCHED; PG8_LDA(At, 0, 0); if constexpr (GATHER) PG8_STAGE_G(PG8_SA(1, 1), gcur, 1, k1); else PG8_STAGE(PG8_SA(1, 1), a1 + hstep, voffA);
            PG8_WAIT_V(8); PG8_WAIT_L(0); PG8_BAR; PG8_MMA(0, 0, At, B0); PG8_MMA(0, 1, At, B1); PG8_BAR; PG8_SCHED;
            PG8_LDA(At, 0, 1); PG8_STAGE(PG8_SB(0, 0), b2, voffB); PG8_STAGE(PG8_SB(0, 1), b2 + hstep, voffB); if constexpr (GATHER) PG8_STAGE_G(PG8_SA(0, 0), g2, 0, k2); else PG8_STAGE(PG8_SA(0, 0), a2, voffA);
            PG8_WAIT_V(8); PG8_WAIT_L(0); PG8_BAR; PG8_MMA(1, 0, At, B0); PG8_MMA(1, 1, At, B1); PG8_BAR; PG8_SCHED;
            PG8_LDB(B0, 1, 0); PG8_LDB(B1, 1, 1); PG8_SCHED; PG8_LDA(At, 1, 0); if constexpr (GATHER) PG8_STAGE_G(PG8_SA(0, 1), g2, 1, k2); else PG8_STAGE(PG8_SA(0, 1), a2 + hstep, voffA);
            PG8_WAIT_V(8); PG8_WAIT_L(0); PG8_BAR; PG8_MMA(0, 0, At, B0); PG8_MMA(0, 1, At, B1); PG8_BAR; PG8_SCHED;
            PG8_LDA(At, 1, 1); PG8_STAGE(PG8_SB(1, 0), b3, voffB); PG8_STAGE(PG8_SB(1, 1), b3 + hstep, voffB); if constexpr (GATHER) PG8_STAGE_G(PG8_SA(1, 0), g2, 0, k2 + kstep); else PG8_STAGE(PG8_SA(1, 0), a3, voffA);
            PG8_WAIT_V(8); PG8_WAIT_L(0); PG8_BAR; PG8_MMA(1, 0, At, B0); PG8_MMA(1, 1, At, B1); PG8_BAR; PG8_SCHED;
            } else {
            PG8_LDB(B0, 0, 0); PG8_SCHED; PG8_LDA(At, 0, 0); PG8_STAGE(PG8_SA(1, 1), a1 + hstep, voffA);
            PG8_WAIT_L(8); PG8_BAR; PG8_WAIT_L(0); PG8_MMA(0, 0, At, B0); PG8_BAR; PG8_SCHED;
            PG8_LDB(B1, 0, 1); PG8_STAGE(PG8_SB(0, 0), b2, voffB);
            PG8_BAR; PG8_WAIT_L(0); PG8_MMA(0, 1, At, B1); PG8_BAR;
            PG8_LDA(At, 0, 1); PG8_STAGE(PG8_SA(0, 0), a2, voffA);
            PG8_BAR; PG8_WAIT_L(0); PG8_MMA(1, 0, At, B0); PG8_BAR; PG8_SCHED;
            PG8_STAGE(PG8_SB(0, 1), b2 + hstep, voffB);
            PG8_WAIT_V(6); PG8_BAR; PG8_MMA(1, 1, At, B1); PG8_BAR;
            PG8_LDB(B0, 1, 0); PG8_SCHED; PG8_LDA(At, 1, 0); PG8_STAGE(PG8_SA(0, 1), a2 + hstep, voffA);
            PG8_WAIT_L(8); PG8_BAR; PG8_WAIT_L(0); PG8_MMA(0, 0, At, B0); PG8_BAR; PG8_SCHED;
            PG8_LDB(B1, 1, 1); PG8_STAGE(PG8_SB(1, 0), b3, voffB);
            PG8_BAR; PG8_WAIT_L(0); PG8_MMA(0, 1, At, B1); PG8_BAR;
            PG8_LDA(At, 1, 1); PG8_STAGE(PG8_SA(1, 0), a3, voffA);
            PG8_BAR; PG8_WAIT_L(0); PG8_MMA(1, 0, At, B0); PG8_BAR; PG8_SCHED;
            PG8_STAGE(PG8_SB(1, 1), b3 + hstep, voffB);
            PG8_WAIT_V(6); PG8_BAR; PG8_MMA(1, 1, At, B1); PG8_BAR;
            }
        }
        if constexpr (ALIGN_EPI) { if (wr == 0) PG8_BAR; }
        if constexpr (!Epi::AFTER_DRAIN) { E(acc, cur, wr, wc, fr, fq); S.done(cur); }
        if (!has_next) break;
#pragma unroll
        for (int a = 0; a < 2; ++a)
#pragma unroll
            for (int b = 0; b < 2; ++b)
#pragma unroll
                for (int m = 0; m < 4; ++m)
#pragma unroll
                    for (int n = 0; n < 2; ++n) acc[a][b][m][n] = (f32x4){0.f, 0.f, 0.f, 0.f};
        cur = nxt; cA = nA; cB = nB; ++ui;
        if constexpr (GATHER) { _Pragma("unroll") for (int h_ = 0; h_ < 2; ++h_) _Pragma("unroll") for (int i_ = 0; i_ < 2; ++i_) gcur[h_][i_] = gnxt[h_][i_]; }
        if constexpr (ALIGN_EPI) { if (wr == 1) PG8_BAR; }
    }
    PG8_WAIT_V(0);
    if constexpr (!ALIGN_EPI) { if (wr == 0) PG8_BAR; }
    PG8_BAR;
    if constexpr (Epi::AFTER_DRAIN) { E.fused(acc, cur, wr, wc, fr, fq, lds, wid, lane); S.done(cur); }
#undef PG8_SA
#undef PG8_SB
#undef PG8_STAGE
#undef PG8_STAGE_G
#undef PG8_GIDX
#undef PG8_LDA
#undef PG8_LDB
#undef PG8_MMA
#undef PG8_WAIT_V
#undef PG8_WAIT_L
#undef PG8_BAR
#undef PG8_SCHED
}
}

namespace attc {
using bf16 = __hip_bfloat16;
constexpr int   D = 128, NW = 8, QBLK = 32, KVBLK = 64;
constexpr float SCALE = 0.088388347648318440f;
constexpr float THR = 8.f;
constexpr int LAYOUT = 1, SDEPTH = 1;
constexpr int HQ = 8, HKV = 2;
constexpr int LDQ = HQ * D, LDK = HKV * D, LDO = LDQ;
constexpr size_t SHM_V = KVBLK * D * 2, SHM_K = KVBLK * D * 2, SHM_ATTN = 2 * SHM_V + 2 * SHM_K + NW * 64 * 4;
using bf16x8 = __attribute__((ext_vector_type(8))) short;
using s16x4  = __attribute__((ext_vector_type(4))) short;
using f32x16 = __attribute__((ext_vector_type(16))) float;
using f32x8  = __attribute__((ext_vector_type(8))) float;
using u32x4  = __attribute__((ext_vector_type(4))) unsigned;
#define KSWZ(row, colB) ((row) * 256 + ((colB) ^ (((row) & 7) << 4)))
#define SBAR() __builtin_amdgcn_sched_barrier(0)
__device__ __forceinline__ int crow(int r, int hi) { return (r & 3) + 8 * (r >> 2) + 4 * hi; }
__device__ __forceinline__ unsigned cvtpk(float lo, float hi) {
  unsigned r; asm volatile("v_cvt_pk_bf16_f32 %0, %1, %2" : "=v"(r) : "v"(lo), "v"(hi)); return r;
}
template <typename TIn> struct Stage;
template <> struct Stage<bf16>  { using T = bf16x8;
  __device__ static __forceinline__ T ld8(const bf16* p) { return *reinterpret_cast<const bf16x8*>(p); }
  __device__ static __forceinline__ bf16x8 tobf(T x) { return x; } };
template <> struct Stage<float> { using T = f32x8;
  __device__ static __forceinline__ T ld8(const float* p) { return *reinterpret_cast<const f32x8*>(p); }
  __device__ static __forceinline__ bf16x8 tobf(T x) {
    u32x4 w = {cvtpk(x[0], x[1]), cvtpk(x[2], x[3]), cvtpk(x[4], x[5]), cvtpk(x[6], x[7])}; return *reinterpret_cast<bf16x8*>(&w); } };

__device__ __forceinline__ void partialSM(f32x16& p0, f32x16& p1, float& m_reg, float& mn, float& alpha) {
  constexpr float C = SCALE * 1.4426950408889634f;
  float pmax = p0[0]; for (int r = 1; r < 16; ++r) pmax = fmaxf(pmax, p0[r]); for (int r = 0; r < 16; ++r) pmax = fmaxf(pmax, p1[r]);
  { auto rr = __builtin_amdgcn_permlane32_swap(__float_as_uint(pmax), __float_as_uint(pmax), false, false);
    pmax = fmaxf(__uint_as_float(rr[0]), __uint_as_float(rr[1])); }
  if (__builtin_expect(__all(pmax - m_reg <= THR / SCALE), 1)) { mn = m_reg; alpha = 1.f; }
  else { mn = fmaxf(m_reg, pmax); alpha = __builtin_amdgcn_exp2f((m_reg - mn) * C); m_reg = mn; }
  float mnC = -mn * C;
  for (int r = 0; r < 16; ++r) p0[r] = fmaf(p0[r], C, mnC); for (int r = 0; r < 16; ++r) p1[r] = fmaf(p1[r], C, mnC);
  for (int r = 0; r < 16; ++r) p0[r] = __builtin_amdgcn_exp2f(p0[r]);
}
__device__ __forceinline__ void finishSM(f32x16& p0, f32x16& p1, float alpha, float& l_reg, bf16x8& pa0, bf16x8& pa1, bf16x8& pa2, bf16x8& pa3) {
  for (int r = 0; r < 16; ++r) p1[r] = __builtin_amdgcn_exp2f(p1[r]);
  float ps = 0; for (int r = 0; r < 16; ++r) ps += p0[r]; for (int r = 0; r < 16; ++r) ps += p1[r];
  { auto rr = __builtin_amdgcn_permlane32_swap(__float_as_uint(ps), __float_as_uint(ps), false, false);
    ps = __uint_as_float(rr[0]) + __uint_as_float(rr[1]); }
  l_reg = l_reg * alpha + ps;
#define PK4(P, BASE, OUT) do { unsigned a0 = cvtpk(P[BASE + 0], P[BASE + 1]), a1 = cvtpk(P[BASE + 2], P[BASE + 3]);   \
    unsigned b0 = cvtpk(P[BASE + 4], P[BASE + 5]), b1 = cvtpk(P[BASE + 6], P[BASE + 7]);                              \
    auto r0 = __builtin_amdgcn_permlane32_swap(a0, b0, false, false); auto r1 = __builtin_amdgcn_permlane32_swap(a1, b1, false, false); \
    u32x4 w = {r0[0], r1[0], r0[1], r1[1]}; OUT = *reinterpret_cast<bf16x8*>(&w); } while (0)
  PK4(p0, 0, pa0); PK4(p0, 8, pa1); PK4(p1, 0, pa2); PK4(p1, 8, pa3);
#undef PK4
}
__device__ __forceinline__ void qkt(f32x16& p0, f32x16& p1, const bf16* Ks, const bf16x8* qr, int r32, int hi) {
  p0 = f32x16{}; p1 = f32x16{};
  for (int d0 = 0; d0 < 8; ++d0) { int cb = (d0 * 16 + hi * 8) * 2;
    bf16x8 b0 = *reinterpret_cast<const bf16x8*>((const char*)Ks + KSWZ(r32, cb));
    bf16x8 b1 = *reinterpret_cast<const bf16x8*>((const char*)Ks + KSWZ(32 + r32, cb));
    p0 = __builtin_amdgcn_mfma_f32_32x32x16_bf16(b0, qr[d0], p0, 0, 0, 0);
    p1 = __builtin_amdgcn_mfma_f32_32x32x16_bf16(b1, qr[d0], p1, 0, 0, 0); }
}
__device__ __forceinline__ int v_st(int k, int c) { const int kk = (k & ~0xC) | ((k & 4) << 1) | ((k & 8) >> 1); return ((kk >> 3) * 4 + (c >> 5)) * 512 + ((kk & 7) * 32 + (c & 31)) * 2; }
__device__ __forceinline__ int v_rd_base(int lane) { return ((lane & 3) << 3) | (((lane >> 2) & 3) << 6) | (((lane >> 4) & 1) << 5) | (((lane >> 5) & 1) << 8); }
constexpr int v_rd_off(int d0, int ks, int half) { return d0 * 512 + ks * 4096 + half * 2048; }
template <int OFF> __device__ __forceinline__ s16x4 tr_read(int vb) {
  s16x4 r; asm volatile("ds_read_b64_tr_b16 %0, %1 offset:%2" : "=&v"(r) : "v"(vb), "i"(OFF) : "memory"); return r;
}
template <int D0> __device__ __forceinline__ void pv_one(f32x16& od, int vb, bf16x8 pa0, bf16x8 pa1, bf16x8 pa2, bf16x8 pa3) {
  const s16x4 l0 = tr_read<v_rd_off(D0, 0, 0)>(vb), h0 = tr_read<v_rd_off(D0, 0, 1)>(vb), l1 = tr_read<v_rd_off(D0, 1, 0)>(vb), h1 = tr_read<v_rd_off(D0, 1, 1)>(vb);
  const s16x4 l2 = tr_read<v_rd_off(D0, 2, 0)>(vb), h2 = tr_read<v_rd_off(D0, 2, 1)>(vb), l3 = tr_read<v_rd_off(D0, 3, 0)>(vb), h3 = tr_read<v_rd_off(D0, 3, 1)>(vb);
  asm volatile("s_waitcnt lgkmcnt(0)" ::: "memory"); SBAR();
#define PK(L, H) (bf16x8){L[0], L[1], L[2], L[3], H[0], H[1], H[2], H[3]}
  od = __builtin_amdgcn_mfma_f32_32x32x16_bf16(pa0, PK(l0, h0), od, 0, 0, 0);
  od = __builtin_amdgcn_mfma_f32_32x32x16_bf16(pa1, PK(l1, h1), od, 0, 0, 0);
  od = __builtin_amdgcn_mfma_f32_32x32x16_bf16(pa2, PK(l2, h2), od, 0, 0, 0);
  od = __builtin_amdgcn_mfma_f32_32x32x16_bf16(pa3, PK(l3, h3), od, 0, 0, 0);
#undef PK
}
__device__ __forceinline__ void pv_d0(f32x16* o, int vb, bf16x8 pa0, bf16x8 pa1, bf16x8 pa2, bf16x8 pa3) {
  pv_one<0>(o[0], vb, pa0, pa1, pa2, pa3); pv_one<1>(o[1], vb, pa0, pa1, pa2, pa3); pv_one<2>(o[2], vb, pa0, pa1, pa2, pa3); pv_one<3>(o[3], vb, pa0, pa1, pa2, pa3);
}

template <typename TQ>
__device__ __forceinline__ void attn_dense_body(const TQ* Qb, const bf16* Kh, const bf16* Vh,
                                                bf16_raw* Ob, int seq, char* lds) {
  using St = Stage<bf16>; using SQ = Stage<TQ>;
  const int tid = opaque_tid(), wid = tid >> 6, lane = tid & 63, r32 = lane & 31, hi = lane >> 5;
  bf16* V_lds = (bf16*)lds; bf16* K_lds = (bf16*)(lds + 2 * SHM_V);
  float* ws = (float*)(lds + 2 * SHM_V + 2 * SHM_K) + wid * 64; float* li_l = ws; float* al_l = ws + 32;
  float m_reg = -1e30f, l_reg = 0; f32x16 o[4] = {}; bf16x8 qr[8];
  const TQ* Qw = Qb + (long)(wid * QBLK + r32) * LDQ + hi * 8;
#pragma unroll
  for (int d0 = 0; d0 < 8; ++d0) qr[d0] = SQ::tobf(SQ::ld8(Qw + d0 * 16));
  const int sr = tid >> 4, sc = (tid & 15) * 8, vst0 = v_st(sr, sc), vst1 = v_st(32 + sr, sc);
  const int vb0 = (int)(uintptr_t)V_lds + v_rd_base(lane);
  struct { typename St::T vs0, vs1, ks0, ks1; } sr_[SDEPTH];
#define SLOAD(i, k0) do { sr_[i].vs0 = St::ld8(&Vh[(long)((k0) + sr) * LDK + sc]); sr_[i].vs1 = St::ld8(&Vh[(long)((k0) + 32 + sr) * LDK + sc]); \
    sr_[i].ks0 = St::ld8(&Kh[(long)((k0) + sr) * LDK + sc]); sr_[i].ks1 = St::ld8(&Kh[(long)((k0) + 32 + sr) * LDK + sc]); } while (0)
#define SWRITE(b, i) do { *(bf16x8*)((char*)V_lds + (b) * SHM_V + vst0) = St::tobf(sr_[i].vs0);          \
    *(bf16x8*)((char*)V_lds + (b) * SHM_V + vst1) = St::tobf(sr_[i].vs1); int kc = sc * 2;               \
    *(bf16x8*)((char*)K_lds + (b) * SHM_K + KSWZ(sr, kc)) = St::tobf(sr_[i].ks0);                       \
    *(bf16x8*)((char*)K_lds + (b) * SHM_K + KSWZ(32 + sr, kc)) = St::tobf(sr_[i].ks1); } while (0)
#define SWAIT() do { if constexpr (SDEPTH == 2) asm volatile("s_waitcnt vmcnt(4)" ::: "memory"); else asm volatile("s_waitcnt vmcnt(0)" ::: "memory"); } while (0)
#define RESC(a) do { if (__any((a) < 1.f)) { if (hi == 0) al_l[r32] = (a); asm volatile("s_waitcnt lgkmcnt(0)" ::: "memory"); \
    for (int d = 0; d < 4; ++d) for (int r = 0; r < 16; ++r) o[d][r] *= al_l[crow(r, hi)]; } } while (0)
  f32x16 pA0, pA1, pB0, pB1; float mnA, mnB, alA, alB; bf16x8 pa0, pa1, pa2, pa3; const int NT = seq / KVBLK;
  constexpr int SE = 0, SO = SDEPTH - 1;
  SLOAD(SE, 0); asm volatile("s_waitcnt vmcnt(0)" ::: "memory"); SWRITE(0, SE); __syncthreads();
  qkt(pA0, pA1, K_lds, qr, r32, hi); partialSM(pA0, pA1, m_reg, mnA, alA);
  SLOAD(SO, KVBLK); if constexpr (SDEPTH == 2) { if (2 < NT) SLOAD(SE, 2 * KVBLK); }
  SWAIT(); SWRITE(1, SO); __syncthreads();
  asm volatile(".p2alignl 7, 0xBF800000");
  for (int j = 1; j + 1 < NT; j += 2) {
    SBAR(); qkt(pB0, pB1, (bf16*)((char*)K_lds + SHM_K), qr, r32, hi);
    finishSM(pA0, pA1, alA, l_reg, pa0, pa1, pa2, pa3); SBAR();
    SLOAD(SO, (j + SDEPTH) * KVBLK); SBAR();
    pv_d0(o, vb0, pa0, pa1, pa2, pa3); partialSM(pB0, pB1, m_reg, mnB, alB);
    __syncthreads(); SWAIT(); SWRITE(0, SE);
    RESC(alB); __syncthreads();
    SBAR(); qkt(pA0, pA1, K_lds, qr, r32, hi);
    finishSM(pB0, pB1, alB, l_reg, pa0, pa1, pa2, pa3); SBAR();
    if (SDEPTH == 1 || j + 3 < NT) SLOAD(SE, (j + 1 + SDEPTH) * KVBLK); SBAR();
    pv_d0(o, vb0 + (int)SHM_V, pa0, pa1, pa2, pa3); partialSM(pA0, pA1, m_reg, mnA, alA);
    __syncthreads(); SWAIT(); SWRITE(1, SO);
    RESC(alA); __syncthreads();
  }
  SBAR(); qkt(pB0, pB1, (bf16*)((char*)K_lds + SHM_K), qr, r32, hi);
  finishSM(pA0, pA1, alA, l_reg, pa0, pa1, pa2, pa3); SBAR();
  pv_d0(o, vb0, pa0, pa1, pa2, pa3); partialSM(pB0, pB1, m_reg, mnB, alB);
  __syncthreads(); RESC(alB);
  finishSM(pB0, pB1, alB, l_reg, pa0, pa1, pa2, pa3); SBAR();
  pv_d0(o, vb0 + (int)SHM_V, pa0, pa1, pa2, pa3);
  if (hi == 0) li_l[r32] = l_reg; asm volatile("s_waitcnt lgkmcnt(0)" ::: "memory");
  float rli[16];
#pragma unroll
  for (int r = 0; r < 16; ++r) rli[r] = __builtin_amdgcn_rcpf(li_l[crow(r, hi)]);
  bf16_raw* Ow = Ob + (long)(wid * QBLK) * LDO;
#pragma unroll
  for (int r = 0; r < 16; ++r) { int orow = crow(r, hi);
    for (int d0 = 0; d0 < 4; ++d0) Ow[(long)orow * LDO + d0 * 32 + r32] = f2bf_rne(o[d0][r] * rli[r]); }
#undef SLOAD
#undef SWRITE
#undef SWAIT
#undef RESC
}
}
#define XB_TMO      128
#define XB_XCNT(j)  (256  + 64 * (j))
#define XB_XSUB(j)  (1280 + 64 * (j))
#define XB_XGEN(j)  (2304 + 64 * (j))
#define XB_TOP      3328
#define XB_TOPGEN   3392
#define XCD_BAR_WORDS 3456
#define XB_SPIN_CAP (1u << 18)

__device__ __forceinline__ unsigned xb_ld(unsigned* p)              { return __hip_atomic_load(p, __ATOMIC_RELAXED, __HIP_MEMORY_SCOPE_AGENT); }
__device__ __forceinline__ unsigned xb_add(unsigned* p, unsigned v) { return __hip_atomic_fetch_add(p, v, __ATOMIC_RELAXED, __HIP_MEMORY_SCOPE_AGENT); }
__device__ __forceinline__ unsigned xb_xcc_id() { return (unsigned)__builtin_amdgcn_s_getreg((3 << 11) | 20) & 0xFu; }
#define XB_SPIN(cond, bar) do { unsigned _sp = 0; while (cond) { __builtin_amdgcn_s_sleep(1); \
    if ((++_sp & 255u) == 0u) { if (xb_ld(&(bar)[XB_TMO])) break; if (_sp > XB_SPIN_CAP) { atomicAdd(&(bar)[XB_TMO], 1u); break; } } } } while (0)

struct XcdBarrier {
    unsigned* bar; unsigned x;
    volatile LAS unsigned* st;
};

__device__ __forceinline__ XcdBarrier xcd_barrier_post(unsigned* bar, volatile LAS unsigned* st) {
    XcdBarrier b; b.bar = bar; b.x = xb_xcc_id(); b.st = st;
    if (threadIdx.x == 0) (void)xb_add(&bar[XB_XCNT(b.x)], 1u);
    return b;
}
__device__ __forceinline__ void xcd_barrier_complete(unsigned* bar, unsigned x, unsigned& nloc, unsigned& nx) {
    const unsigned G = gridDim.x * gridDim.y * gridDim.z;
    unsigned sum, cnt, mine, sp = 0u;
    for (;;) {
        sum = 0u; cnt = 0u; mine = 0u;
#pragma unroll
        for (unsigned j = 0; j < 16; ++j) { const unsigned c = xb_ld(&bar[XB_XCNT(j)]); sum += c; cnt += (c > 0u) ? 1u : 0u; mine = (j == x) ? c : mine; }
        if (sum == G) break;
        __builtin_amdgcn_s_sleep(1);
        if ((++sp & 255u) == 0u) { if (xb_ld(&bar[XB_TMO])) break; if (sp > XB_SPIN_CAP) { atomicAdd(&bar[XB_TMO], 1u); break; } }
    }
    nloc = mine > 0u ? mine : 1u; nx = cnt > 0u ? cnt : 1u;
}

__device__ __forceinline__ void xcd_barrier(const XcdBarrier& b) {
    asm volatile("s_waitcnt vmcnt(0)" ::: "memory");
    __syncthreads();
    if (threadIdx.x == 0) {
        unsigned* bar = b.bar;
        __builtin_amdgcn_s_waitcnt(0);
        unsigned nloc = b.st[0], nx = b.st[1];
        if (nloc == 0u) { xcd_barrier_complete(bar, b.x, nloc, nx); b.st[0] = nloc; b.st[1] = nx; }
        const unsigned old = xb_add(&bar[XB_XSUB(b.x)], 1u);
        const unsigned gen = old / nloc;
        if (old + 1u == (gen + 1u) * nloc) {
            __builtin_amdgcn_fence(__ATOMIC_RELEASE, "agent");
            asm volatile("s_waitcnt vmcnt(0)" ::: "memory");
            const unsigned og = xb_add(&bar[XB_TOP], 1u);
            const unsigned tg = og / nx;
            if (og + 1u == (tg + 1u) * nx) xb_add(&bar[XB_TOPGEN], 1u);
            else XB_SPIN(xb_ld(&bar[XB_TOPGEN]) == tg, bar);
            __builtin_amdgcn_fence(__ATOMIC_ACQUIRE, "agent");
            xb_add(&bar[XB_XGEN(b.x)], 1u);
            asm volatile("s_waitcnt vmcnt(0)" ::: "memory");
        } else {
            XB_SPIN(xb_ld(&bar[XB_XGEN(b.x)]) == gen, bar);
            __builtin_amdgcn_fence(__ATOMIC_ACQUIRE, "agent");
            asm volatile("s_waitcnt vmcnt(0)" ::: "memory");
        }
    }
    __syncthreads();
}


struct Params { const float* in[25]; float* out; unsigned char* ws; };
enum { I_X = 0, I_C, I_CTX, I_CCTX, I_WMOD, I_BMOD, I_NMIX, I_NFFN, I_WINAB, I_WOUTAB, I_QNA, I_KNA, I_SINK, I_CONV, I_ALOG, I_DTB, I_ONORM,
       I_WINC, I_WOUTC, I_QNC, I_KNC, I_WR, I_WG, I_WU, I_WD };

constexpr int TRI_AB = 16 * 11, TRI_OAB = 16 * 4, TRI_CC = 16 * 6, TRI_OC = 16 * 4, TRI_W1 = 16 * 16, TRI_W2 = 32 * 4;
constexpr int TRI_SMALL = TRI_AB + TRI_OAB + TRI_CC + TRI_OC;
constexpr int TR_SET_A = TRI_SMALL + 16 * TRI_W1 + 16 * TRI_W2, TR_SET_B = 16 * TRI_W1 + 16 * TRI_W2;
__device__ __forceinline__ void tr_items(const Params& p, LAS unsigned char* lds, int set, int first, int stride, int count) {
    const int tid = opaque_tid();
    unsigned char* ws = launder(p.ws);
    const int setsize = set ? TR_SET_B : TR_SET_A;
    LAS float* tile = (LAS float*)lds;
    const int lrow = tid >> 6, col4 = (tid & 63) * 4;
    f32x4_t v[8];
    const float* src0 = nullptr; const float* src1 = nullptr; int ld = 0; bf16_raw* dstp = nullptr; int dK = 0;
#define TR_ITEM(j) (set == 0 ? ((j) < TRI_SMALL + 16 * TRI_W1 ? (j) : (j) + 16 * TRI_W1) : ((j) < 16 * TRI_W1 ? (j) + TRI_SMALL + 16 * TRI_W1 : (j) + TRI_SMALL + 16 * TRI_W1 + 16 * TRI_W2))
#define TR_DECODE(item) do { int r = (item); \
        if (r < TRI_AB) { const int kb = r / 11, nb = r % 11; ld = LDW_AB; src0 = p.in[I_WINAB] + (size_t)(64 * kb) * ld + 256 * nb; src1 = src0 + 128; dK = 1024; dstp = (bf16_raw*)(ws + WS_WINAB) + (size_t)(256 * nb) * 1024 + 64 * kb; break; } r -= TRI_AB; \
        if (r < TRI_OAB) { const int kb = r / 4, nb = r % 4; ld = 1024; src0 = p.in[I_WOUTAB] + (size_t)(64 * kb) * ld + 256 * nb; src1 = src0 + 128; dK = 1024; dstp = (bf16_raw*)(ws + WS_WOUTAB) + (size_t)(256 * nb) * 1024 + 64 * kb; break; } r -= TRI_OAB; \
        if (r < TRI_CC) { const int kb = r / 6, nb = r % 6; ld = NC; src0 = p.in[I_WINC] + (size_t)(64 * kb) * ld + 256 * nb; src1 = src0 + 128; dK = 1024; dstp = (bf16_raw*)(ws + WS_WINC) + (size_t)(256 * nb) * 1024 + 64 * kb; break; } r -= TRI_CC; \
        if (r < TRI_OC) { const int kb = r / 4, nb = r % 4; ld = 1024; src0 = p.in[I_WOUTC] + (size_t)(64 * kb) * ld + 256 * nb; src1 = src0 + 128; dK = 1024; dstp = (bf16_raw*)(ws + WS_WOUTC) + (size_t)(256 * nb) * 1024 + 64 * kb; break; } r -= TRI_OC; \
        if (r < 32 * TRI_W1) { const int le = r / TRI_W1, q = r % TRI_W1, kb = q / 16, pn = q % 16; ld = 2048; \
            src0 = p.in[I_WG] + (size_t)le * 1024 * 2048 + (size_t)(64 * kb) * ld + 128 * pn; src1 = p.in[I_WU] + (size_t)le * 1024 * 2048 + (size_t)(64 * kb) * ld + 128 * pn; \
            dK = 1024; dstp = (bf16_raw*)(ws + WS_W1) + (size_t)le * 4096 * 1024 + (size_t)(256 * pn) * 1024 + 64 * kb; break; } r -= 32 * TRI_W1; \
        { const int le = r / TRI_W2, q = r % TRI_W2, kb = q / 4, nb = q % 4; ld = 1024; src0 = p.in[I_WD] + (size_t)le * 2048 * 1024 + (size_t)(64 * kb) * ld + 256 * nb; src1 = src0 + 128; \
          dK = 2048; dstp = (bf16_raw*)(ws + WS_W2) + (size_t)le * 1024 * 2048 + (size_t)(256 * nb) * 2048 + 64 * kb; } } while (0)
#define TR_LOAD() do { const float* s_ = (col4 < 128 ? src0 + col4 : src1 + (col4 - 128)); _Pragma("unroll") for (int i = 0; i < 8; ++i) v[i] = __builtin_nontemporal_load((const f32x4_t*)(s_ + (size_t)(lrow + 8 * i) * ld)); } while (0)
    int j = first, k = 0;
    if (k < count && j < setsize) { TR_DECODE(TR_ITEM(j)); TR_LOAD(); }
    for (; k < count && j < setsize; ++k, j += stride) {
        bf16_raw* dcur = dstp; const int kcur = dK;
        __syncthreads();
#pragma unroll
        for (int i = 0; i < 8; ++i) { const int row = lrow + 8 * i; *(LAS f32x4_t*)(tile + row * 260 + 4 * ((col4 >> 2) ^ ((row >> 3) & 7))) = v[i]; }
        if (k + 1 < count && j + stride < setsize) { TR_DECODE(TR_ITEM(j + stride)); TR_LOAD(); }
        __syncthreads();
#pragma unroll
        for (int j4 = 0; j4 < 4; ++j4) {
            const int id = tid + 512 * j4, c = id & 7, n = id >> 3;
            const LAS float* s_ = tile + (8 * c) * 260 + 4 * ((n >> 2) ^ c) + (n & 3);
            u32x4_t o; o.x = pk2(s_[0], s_[260]); o.y = pk2(s_[2 * 260], s_[3 * 260]); o.z = pk2(s_[4 * 260], s_[5 * 260]); o.w = pk2(s_[6 * 260], s_[7 * 260]);
            __builtin_nontemporal_store(o, (u32x4_t*)(dcur + (size_t)n * kcur + 8 * c));
        }
    }
    __syncthreads();
#undef TR_ITEM
#undef TR_DECODE
#undef TR_LOAD
}
__device__ __forceinline__ void phase_prep_weights(const Params& p, LAS unsigned char* lds, int bg_end) {
    const int tid = opaque_tid(), lane = tid & 63, wave = tid >> 6, G = gridDim.x, bid = blockIdx.x;
    unsigned char* ws = launder(p.ws);
    for (int modrep = 0; modrep < (PROBE == 20 ? 2 : 1); ++modrep)
    if (bid < 192) {
        const int l = bid / 96, j = (bid % 96) * 64 + lane;
        const float* wm = p.in[I_WMOD] + (size_t)l * 1024 * 6144 + j;
        LAS float* sc = (LAS float*)lds;
        {
            float xv[6];
#pragma unroll
            for (int k = 0; k < 6; ++k) { const int i = tid + NTHREADS * k; xv[k] = (i < 2048) ? p.in[I_C][i] : p.in[I_CCTX][i - 2048]; }
#pragma unroll
            for (int k = 0; k < 6; ++k) sc[tid + NTHREADS * k] = silu_f(xv[k]);
        }
        __syncthreads();
        float a0 = 0.f, a1 = 0.f, a2 = 0.f;
        for (int k0 = 0; k0 < 1024; k0 += 256) {
            float wv[32];
#pragma unroll
            for (int i = 0; i < 32; ++i) wv[i] = __builtin_nontemporal_load(wm + (size_t)(k0 + wave + 8 * i) * 6144);
#pragma unroll
            for (int i = 0; i < 32; ++i) { const int k = k0 + wave + 8 * i; a0 += sc[k] * wv[i]; a1 += sc[1024 + k] * wv[i]; a2 += sc[2048 + k] * wv[i]; }
        }
        __syncthreads();
        LAS float* red = (LAS float*)(lds + 131072);
        red[(wave * 3 + 0) * 64 + lane] = a0; red[(wave * 3 + 1) * 64 + lane] = a1; red[(wave * 3 + 2) * 64 + lane] = a2;
        __syncthreads();
        if (wave < 3) {
            float s = 0.f;
#pragma unroll
            for (int w = 0; w < 8; ++w) s += red[(w * 3 + wave) * 64 + lane];
            float* MOD = (float*)(ws + WS_MOD);
            MOD[(size_t)(l * 3 + wave) * 6144 + j] = s + p.in[I_BMOD][l * 6144 + j];
        }
        __syncthreads();
    }
    if (bid >= 192 && bid < 204) {
        const int g = (bid - 192) * NTHREADS + tid;
        if (g < 6144) {
            const int q = g < 2048 ? 16 : 32, gg = g < 2048 ? g : g - 2048, pos = gg / q, i = gg % q;
            const float inv = powf(10000.f, -(float)i / (float)q), ang = (float)pos * inv;
            float sn, cs; sincosf(ang, &sn, &cs);
            ((f32x2_t*)(ws + WS_ROPE))[g] = (f32x2_t){cs, sn};
        }
    }
    if (bg_end == -1) return;
    tr_items(p, lds, 0, bid, G, (TR_SET_A + G - 1) / G);
    if (bg_end < TR_SET_B) tr_items(p, lds, 1, bg_end + bid, G, (TR_SET_B - bg_end + G - 1) / G);
}

template <int MODE>
__device__ __forceinline__ void norm_dots(const f32x4_t (&h)[4], LAS float* wt, int lane, float (&a)[16]) {
#pragma unroll
    for (int e = 0; e < 16; ++e) {
        float s = 0.f;
#pragma unroll
        for (int j = 0; j < 4; ++j) { const f32x4_t w4 = *(const LAS f32x4_t*)(wt + e * 1024 + 4 * lane + 256 * j); s += h[j].x * w4.x + h[j].y * w4.y + h[j].z * w4.z + h[j].w * w4.w; }
        a[e] = s;
        if ((e & 3) == 3) __builtin_amdgcn_sched_barrier(0);
    }
#pragma unroll
    for (int e = 0; e < 16; ++e) a[e] = wave_sum(a[e]);
}
__device__ __forceinline__ void norm_apply(f32x4_t (&v)[4], const float* gain, const float* modp, int lane) {
    float ss = 0.f;
#pragma unroll
    for (int j = 0; j < 4; ++j) ss += v[j].x * v[j].x + v[j].y * v[j].y + v[j].z * v[j].z + v[j].w * v[j].w;
    const float rms = rsqrtf(wave_sum(ss) * (1.f / 1024.f) + EPS);
#pragma unroll
    for (int j = 0; j < 4; ++j) {
        const int k = 4 * lane + 256 * j;
        const f32x4_t g = *(const f32x4_t*)(gain + k), sh = *(const f32x4_t*)(modp + k), sc = *(const f32x4_t*)(modp + 1024 + k);
        v[j] = (v[j] * rms * g) * (sc + 1.f) + sh;
    }
}
__device__ __forceinline__ void store_h(const f32x4_t (&v)[4], bf16_raw* hrow, int lane) {
#pragma unroll
    for (int j = 0; j < 4; ++j) { u32x2_t w; w.x = pk2(v[j].x, v[j].y); w.y = pk2(v[j].z, v[j].w); *(u32x2_t*)(hrow + 4 * lane + 256 * j) = w; }
}
template <int MODE>
__device__ __forceinline__ void row_aux(const f32x4_t (&v)[4], LAS float* wt, int lane, int r, float* aux) {
    if (MODE == 0) return;
    float a[16]; norm_dots<MODE>(v, wt, lane, a);
    if (MODE == 2) {
        float mx = a[0];
#pragma unroll
        for (int e = 1; e < 16; ++e) mx = fmaxf(mx, a[e]);
        float sum = 0.f;
#pragma unroll
        for (int e = 0; e < 16; ++e) { a[e] = expf(a[e] - mx); sum += a[e]; }
        const float inv = 1.f / sum;
#pragma unroll
        for (int e = 0; e < 16; ++e) a[e] *= inv;
    }
    float val = 0.f;
#pragma unroll
    for (int e = 0; e < 16; ++e) if (lane == e) val = a[e];
    if (lane < 16) {
        if (MODE == 1) aux[(size_t)r * 16 + lane] = val;
        else { if (r < MLAT) aux[(size_t)((r >> 13) * 16 + lane) * SEQ + (r & (SEQ - 1))] = val;
               else { const int rc = r - MLAT; aux[(size_t)2 * 16 * SEQ + (size_t)((rc >> 8) * 16 + lane) * CTXL + (rc & 255)] = val; } }
    }
}
__device__ __forceinline__ void stage_w16(const float* W16, int ldw, LAS float* wt) {
    const int tid = opaque_tid();
    f32x4_t v[8];
#pragma unroll
    for (int i = 0; i < 8; ++i) { const int id = tid + NTHREADS * i, k = id >> 2, e4 = id & 3; v[i] = *(const f32x4_t*)(W16 + (size_t)k * ldw + 4 * e4); }
#pragma unroll
    for (int i = 0; i < 8; ++i) { const int id = tid + NTHREADS * i, k = id >> 2, e4 = id & 3;
        wt[(4 * e4 + 0) * 1024 + k] = v[i].x; wt[(4 * e4 + 1) * 1024 + k] = v[i].y; wt[(4 * e4 + 2) * 1024 + k] = v[i].z; wt[(4 * e4 + 3) * 1024 + k] = v[i].w; }
    __syncthreads();
}
template <int MODE>
__device__ __forceinline__ void norm_dots2(const f32x4_t (&h0)[4], const f32x4_t (&h1)[4], LAS float* wt, int lane, float (&a0)[16], float (&a1)[16]) {
    LAS float* wtl = wt + 4 * lane;
#pragma unroll
    for (int e = 0; e < 16; ++e) {
        float s0 = 0.f, s1 = 0.f;
#pragma unroll
        for (int j = 0; j < 4; ++j) { const f32x4_t w4 = *(const LAS f32x4_t*)(wtl + e * 1024 + 256 * j);
            s0 += h0[j].x * w4.x + h0[j].y * w4.y + h0[j].z * w4.z + h0[j].w * w4.w; s1 += h1[j].x * w4.x + h1[j].y * w4.y + h1[j].z * w4.z + h1[j].w * w4.w; }
        a0[e] = s0; a1[e] = s1;
        if ((e & 3) == 3) __builtin_amdgcn_sched_barrier(0);
    }
#pragma unroll
    for (int e = 0; e < 16; ++e) { a0[e] = wave_sum(a0[e]); a1[e] = wave_sum(a1[e]); }
}
template <int MODE>
__device__ __forceinline__ void aux_store(float (&a)[16], int lane, int r, float* aux) {
    if (MODE == 2) {
        float mx = a[0];
#pragma unroll
        for (int e = 1; e < 16; ++e) mx = fmaxf(mx, a[e]);
        float sum = 0.f;
#pragma unroll
        for (int e = 0; e < 16; ++e) { a[e] = expf(a[e] - mx); sum += a[e]; }
        const float inv = 1.f / sum;
#pragma unroll
        for (int e = 0; e < 16; ++e) a[e] *= inv;
    }
    float val = 0.f;
#pragma unroll
    for (int e = 0; e < 16; ++e) if (lane == e) val = a[e];
    if (lane < 16) {
        if (MODE == 1) aux[(size_t)r * 16 + lane] = val;
        else { if (r < MLAT) aux[(size_t)((r >> 13) * 16 + lane) * SEQ + (r & (SEQ - 1))] = val;
               else { const int rc = r - MLAT; aux[(size_t)2 * 16 * SEQ + (size_t)((rc >> 8) * 16 + lane) * CTXL + (rc & 255)] = val; } }
    }
}
template <int MODE>
__device__ __forceinline__ void pair_aux(const f32x4_t (&h0)[4], const f32x4_t (&h1)[4], LAS float* wt, int lane, int r0, int r1, float* aux) {
    float v[32];
    LAS float* wtl = wt + 4 * lane;
#pragma unroll
    for (int e = 0; e < 16; ++e) {
        float s0 = 0.f, s1 = 0.f;
#pragma unroll
        for (int j = 0; j < 4; ++j) { const f32x4_t w4 = *(const LAS f32x4_t*)(wtl + e * 1024 + 256 * j);
            s0 += h0[j].x * w4.x + h0[j].y * w4.y + h0[j].z * w4.z + h0[j].w * w4.w; s1 += h1[j].x * w4.x + h1[j].y * w4.y + h1[j].z * w4.z + h1[j].w * w4.w; }
        v[e] = s0; v[16 + e] = s1;
        if ((e & 3) == 3) __builtin_amdgcn_sched_barrier(0);
    }
#define BFLY(H, MASK) do { const bool up_ = (lane & (MASK)) != 0; _Pragma("unroll") for (int i = 0; i < (H); ++i) { const float send_ = up_ ? v[i] : v[i + (H)], keep_ = up_ ? v[i + (H)] : v[i]; v[i] = keep_ + __shfl_xor(send_, (MASK)); } } while (0)
    BFLY(16, 32); BFLY(8, 16); BFLY(4, 8); BFLY(2, 4); BFLY(1, 2);
#undef BFLY
    float val = v[0] + __shfl_xor(v[0], 1);
    const int r = (lane & 32) ? r1 : r0, e = (lane >> 1) & 15;
    if (MODE == 2) {
        float mx = val;
#pragma unroll
        for (int m = 2; m <= 16; m <<= 1) mx = fmaxf(mx, __shfl_xor(mx, m));
        const float ex = expf(val - mx);
        float sum = ex;
#pragma unroll
        for (int m = 2; m <= 16; m <<= 1) sum += __shfl_xor(sum, m);
        val = ex / sum;
    }
    if ((lane & 1) == 0) {
        if (MODE == 1) aux[(size_t)r * 16 + e] = val;
        else { if (r < MLAT) aux[(size_t)((r >> 13) * 16 + e) * SEQ + (r & (SEQ - 1))] = val;
               else { const int rc = r - MLAT; aux[(size_t)2 * 16 * SEQ + (size_t)((rc >> 8) * 16 + e) * CTXL + (rc & 255)] = val; } }
    }
}
__device__ __forceinline__ void norm_apply2(f32x4_t (&v)[4], const f32x4_t (&gm)[4], const f32x4_t (&sh)[4]) {
    float ss = 0.f;
#pragma unroll
    for (int j = 0; j < 4; ++j) ss += v[j].x * v[j].x + v[j].y * v[j].y + v[j].z * v[j].z + v[j].w * v[j].w;
    const float rms = rsqrtf(wave_sum(ss) * (1.f / 1024.f) + EPS);
#pragma unroll
    for (int j = 0; j < 4; ++j) v[j] = (v[j] * rms) * gm[j] + sh[j];
}
__device__ __forceinline__ void norm_modvec(const float* gain, const float* modp, int lane, f32x4_t (&gm)[4], f32x4_t (&sh)[4]) {
#pragma unroll
    for (int j = 0; j < 4; ++j) { const int k = 4 * lane + 256 * j; const f32x4_t g = *(const f32x4_t*)(gain + k), sc = *(const f32x4_t*)(modp + 1024 + k); sh[j] = *(const f32x4_t*)(modp + k); gm[j] = g * (sc + 1.f); }
}
template <int MODE>
__device__ __forceinline__ void phase_norm(const float* src_lat, const float* src_ctx, int nrows, const float* gain, const float* mod3, bf16_raw* Hout,
                                           const float* W16, int ldw, float* aux, LAS unsigned char* lds) {
    const int tid = opaque_tid(), lane = tid & 63, wave = tid >> 6;
    LAS float* wt = (LAS float*)lds;
    if (MODE != 0) stage_w16(W16, ldw, wt);
    const int gw = blockIdx.x * NWAVES + wave;
#define NORM_LOAD(V, src_) do { _Pragma("unroll") for (int j = 0; j < 4; ++j) V[j] = __builtin_nontemporal_load((const f32x4_t*)((src_) + 4 * lane + 256 * j)); } while (0)
#define NORM_PAIR(V0, V1, R0) do { \
        norm_apply2(V0, gm, sh); norm_apply2(V1, gm, sh); \
        store_h(V0, Hout + (size_t)(R0) * DM, lane); store_h(V1, Hout + (size_t)((R0) + 1) * DM, lane); \
        if (MODE != 0) pair_aux<MODE>(V0, V1, wt, lane, (R0), (R0) + 1, aux); } while (0)
    {
        const int r0 = gw * 8;
        f32x4_t gm[4], sh[4]; norm_modvec(gain, mod3 + (r0 >> 13) * 6144, lane, gm, sh);
        const float* src = src_lat + (size_t)r0 * DM;
        f32x4_t n0[4], n1[4];
        NORM_LOAD(n0, src); NORM_LOAD(n1, src + DM);
#pragma unroll 1
        for (int i = 0; i < 6; i += 2) {
            f32x4_t v0[4], v1[4];
#pragma unroll
            for (int j = 0; j < 4; ++j) { v0[j] = n0[j]; v1[j] = n1[j]; }
            NORM_LOAD(n0, src + (size_t)(i + 2) * DM); NORM_LOAD(n1, src + (size_t)(i + 3) * DM);
            NORM_PAIR(v0, v1, r0 + i);
        }
        NORM_PAIR(n0, n1, r0 + 6);
    }
    if (nrows > MLAT && gw < nrows - MLAT) {
        const int r = MLAT + gw;
        f32x4_t gm[4], sh[4]; norm_modvec(gain, mod3 + 2 * 6144, lane, gm, sh);
        f32x4_t v[4]; NORM_LOAD(v, src_ctx + (size_t)gw * DM);
        norm_apply2(v, gm, sh);
        store_h(v, Hout + (size_t)r * DM, lane);
        row_aux<MODE>(v, wt, lane, r, aux);
    }
#undef NORM_PAIR
#undef NORM_LOAD
}

template <int NE, int QUARTER>
__device__ __forceinline__ void rope_cs(const f32x2_t* tab, int hl0, int t, float* cs, float* sn) {
    const int i0 = hl0 & (QUARTER - 1), axis = (hl0 / (2 * QUARTER)) & 1;
    const int pos = axis ? (t & 63) : (t >> 6);
    const f32x4_t* tp = (const f32x4_t*)(tab + pos * QUARTER + i0);
#pragma unroll
    for (int e = 0; e < NE / 2; ++e) { const f32x4_t w = tp[e]; cs[2 * e] = w.x; sn[2 * e] = w.y; cs[2 * e + 1] = w.z; sn[2 * e + 1] = w.w; }
}
template <int NE, int QUARTER>
__device__ __forceinline__ void rope_apply(float* y, int hl0, const float* cs, const float* sn) {
    const bool first = ((hl0 / QUARTER) & 1) == 0;
#pragma unroll
    for (int e = 0; e < NE; ++e) { const float yp = __shfl_xor(y[e], 2); y[e] = first ? (y[e] * cs[e] - yp * sn[e]) : (y[e] * cs[e] + yp * sn[e]); }
}

__device__ __forceinline__ void phase_prep0(const Params& p, int wg_rank, int n_wgs) {
    const int tid = opaque_tid(), lane = tid & 63, wave = tid >> 6;
    unsigned char* ws = launder(p.ws);
    const bf16_raw* P = (const bf16_raw*)(ws + WS_P);
    bf16_raw* QA = (bf16_raw*)(ws + WS_QA); bf16_raw* KA = (bf16_raw*)(ws + WS_KA); bf16_raw* VA = (bf16_raw*)(ws + WS_VA);
    const f32x2_t* tab = (const f32x2_t*)(ws + WS_ROPE);
    const int gw = wg_rank * NWAVES + wave, NGW = n_wgs * NWAVES;
    const int hl0 = 8 * (lane & 7);
    float qn[8], kn[8];
#pragma unroll
    for (int e = 0; e < 8; ++e) { qn[e] = p.in[I_QNA][hl0 + e]; kn[e] = p.in[I_KNA][hl0 + e]; }
    u32x4_t wq, wk, wqn = {0u, 0u, 0u, 0u}, wkn = {0u, 0u, 0u, 0u};
    int r = gw;
    float cs[8], sn[8], ncs[8], nsn[8];
#pragma unroll
    for (int e = 0; e < 8; ++e) { cs[e] = 1.f; sn[e] = 0.f; ncs[e] = 1.f; nsn[e] = 0.f; }
    if (r < MALL) { const bf16_raw* prow = P + (size_t)r * NAB; wq = __builtin_nontemporal_load((const u32x4_t*)(prow + 8 * lane)); wk = __builtin_nontemporal_load((const u32x4_t*)(prow + 512 + 8 * (lane & 31))); if (r < MLAT) rope_cs<8, 16>(tab, hl0, r & 8191, cs, sn); }
    for (; r < MALL; r += NGW) {
        const int rn = r + NGW;
        if (rn < MALL) { const bf16_raw* prow = P + (size_t)rn * NAB; wqn = __builtin_nontemporal_load((const u32x4_t*)(prow + 8 * lane)); wkn = __builtin_nontemporal_load((const u32x4_t*)(prow + 512 + 8 * (lane & 31))); if (rn < MLAT) rope_cs<8, 16>(tab, hl0, rn & 8191, ncs, nsn); }
        const bool isctx = r >= MLAT; const int rc = isctx ? r - MLAT : r;
        const int b = isctx ? (rc >> 8) : (rc >> 13), t = isctx ? (rc & 255) : (rc & 8191);
        {
            float x[8]; unpack8(wq, x);
            float ss = 0.f;
#pragma unroll
            for (int e = 0; e < 8; ++e) ss += x[e] * x[e];
            ss += __shfl_xor(ss, 1); ss += __shfl_xor(ss, 2); ss += __shfl_xor(ss, 4);
            const float rms = rsqrtf(ss * (1.f / 64.f) + EPS);
#pragma unroll
            for (int e = 0; e < 8; ++e) x[e] = x[e] * rms * qn[e];
            if (!isctx) rope_apply<8, 16>(x, hl0, cs, sn);
            *(u32x4_t*)(QA + (size_t)r * 512 + 8 * lane) = pack8(x);
        }
        {
            float x[8]; unpack8(wk, x);
            float ss = 0.f;
#pragma unroll
            for (int e = 0; e < 8; ++e) ss += x[e] * x[e];
            ss += __shfl_xor(ss, 1); ss += __shfl_xor(ss, 2); ss += __shfl_xor(ss, 4);
            const float rms = rsqrtf(ss * (1.f / 64.f) + EPS);
#pragma unroll
            for (int e = 0; e < 8; ++e) x[e] = x[e] * rms * kn[e];
            if (!isctx) rope_apply<8, 16>(x, hl0, cs, sn);
            const size_t dst = ((size_t)b * TALL + (isctx ? t : CTXL + t)) * 128;
            if (lane < 16) *(u32x4_t*)(KA + dst + 8 * lane) = pack8(x);
            else if (lane < 32) *(u32x4_t*)(VA + dst + 8 * (lane - 16)) = wk;
        }
        wq = wqn; wk = wkn;
#pragma unroll
        for (int e = 0; e < 8; ++e) { cs[e] = ncs[e]; sn[e] = nsn[e]; }
    }
}

typedef short bf16x8_t __attribute__((ext_vector_type(8)));
typedef float f32x16_t __attribute__((ext_vector_type(16)));
__device__ __forceinline__ int crow16(int r, int hi) { return (r & 3) + 8 * (r >> 2) + 4 * hi; }
__device__ __forceinline__ void attnA_unit(const Params& p, LAS unsigned char* lds, int b, int kvh, int qrow0  , int q0, bool latent) {
    constexpr float SCALE = 0.125f, C = SCALE * 1.4426950408889634f;
    constexpr int PITCH = 144;
    const int tid = opaque_tid(), lane = tid & 63, wave = tid >> 6, r32 = lane & 31, hi = lane >> 5;
    unsigned char* ws = launder(p.ws);
    const bf16_raw* QA = (const bf16_raw*)(ws + WS_QA); const bf16_raw* KA = (const bf16_raw*)(ws + WS_KA); const bf16_raw* VA = (const bf16_raw*)(ws + WS_VA);
    bf16_raw* OAB = (bf16_raw*)(ws + WS_OAB);
    LAS float* wsc = (LAS float*)(lds + 4 * 64 * PITCH) + wave * 64;
    const int h = kvh * 4 + (wave >> 1), rowoff = 32 * (wave & 1);
    bf16x8_t qr[4];
    const bf16_raw* qrow = QA + (size_t)(qrow0 + rowoff + r32) * 512 + h * 64 + hi * 8;
#pragma unroll
    for (int d0 = 0; d0 < 4; ++d0) qr[d0] = *(const bf16x8_t*)(qrow + d0 * 16);
    float m_reg = p.in[I_SINK][h] * 8.f, l_reg = 1.f;
    f32x16_t o[2];
#pragma unroll
    for (int d = 0; d < 2; ++d)
#pragma unroll
        for (int r = 0; r < 16; ++r) o[d][r] = 0.f;
    const int q0w = q0 + rowoff;
    const int jlo = q0 < 128 ? (128 - q0) >> 6 : 0, jhi = (SEQ - q0 + 128) >> 6 < 5 ? (SEQ - q0 + 128) >> 6 : 5;
    const int nt = latent ? 4 + jhi - jlo : 4;
    const size_t kvbase = (size_t)b * TALL;
    const int skey = tid >> 3, schunk = tid & 7;
#define TILE_OF(s) ((s) < 4 ? (s) : (s) + jlo)
#define TILE_KI0(tj) ((tj) < 4 ? 64 * (tj) : CTXL + q0 - 128 + 64 * ((tj) - 4))
    u32x4_t kw, vw;
#define ATTNA_LOAD(s) do { const int tj_ = TILE_OF(s); const size_t g = (kvbase + TILE_KI0(tj_) + skey) * 128 + kvh * 64 + 8 * schunk; kw = *(const u32x4_t*)(KA + g); vw = *(const u32x4_t*)(VA + g); } while (0)
#define ATTNA_STAGE(bi) do { LAS unsigned char* Ks_ = lds + (bi) * (2 * 64 * PITCH); LAS unsigned char* Vt_ = Ks_ + 64 * PITCH; \
        *(LAS u32x4_t*)(Ks_ + skey * PITCH + schunk * 16) = kw; \
        u32x4_t vo; vo.x = __shfl_down(vw.x, 8); vo.y = __shfl_down(vw.y, 8); vo.z = __shfl_down(vw.z, 8); vo.w = __shfl_down(vw.w, 8); \
        if ((skey & 1) == 0) { const int kp = skey >> 1; \
            LAS unsigned* vt = (LAS unsigned*)Vt_ + (8 * schunk) * 36 + 4 * ((kp >> 2) ^ schunk) + (kp & 3); \
            vt[0 * 36] = (vw.x & 0xffffu) | (vo.x << 16); vt[1 * 36] = (vw.x >> 16) | (vo.x & 0xffff0000u); \
            vt[2 * 36] = (vw.y & 0xffffu) | (vo.y << 16); vt[3 * 36] = (vw.y >> 16) | (vo.y & 0xffff0000u); \
            vt[4 * 36] = (vw.z & 0xffffu) | (vo.z << 16); vt[5 * 36] = (vw.z >> 16) | (vo.z & 0xffff0000u); \
            vt[6 * 36] = (vw.w & 0xffffu) | (vo.w << 16); vt[7 * 36] = (vw.w >> 16) | (vo.w & 0xffff0000u); } } while (0)
    ATTNA_LOAD(0);
    unsigned touch = 0u;
    if (latent) {
        const int blo = q0 - 128 < 0 ? 0 : q0 - 128, bhi = q0 + 192 > SEQ ? SEQ : q0 + 192, nl = 2 * (bhi - blo);
#pragma unroll
        for (int i = 0; i < 2; ++i) { const int idx = tid + NTHREADS * i;
            if (idx < nl) { const bf16_raw* base = (idx & 1) ? VA : KA; touch |= *(const unsigned*)(base + (kvbase + CTXL + blo + (idx >> 1)) * 128 + kvh * 64); } }
    }
    __syncthreads();
    ATTNA_STAGE(0);
    ATTNA_LOAD(1);
    __syncthreads();
    for (int s = 0; s < nt; ++s) {
        const int tj = TILE_OF(s);
        LAS unsigned char* Ks = lds + (s & 1) * (2 * 64 * PITCH); LAS unsigned char* Vt = Ks + 64 * PITCH;
        f32x16_t p0, p1;
#pragma unroll
        for (int r = 0; r < 16; ++r) { p0[r] = 0.f; p1[r] = 0.f; }
#pragma unroll
        for (int d0 = 0; d0 < 4; ++d0) {
            const int cb = (16 * d0 + 8 * hi) * 2;
            const bf16x8_t k0 = *(const LAS bf16x8_t*)(Ks + r32 * PITCH + cb), k1 = *(const LAS bf16x8_t*)(Ks + (32 + r32) * PITCH + cb);
            p0 = __builtin_amdgcn_mfma_f32_32x32x16_bf16(k0, qr[d0], p0, 0, 0, 0);
            p1 = __builtin_amdgcn_mfma_f32_32x32x16_bf16(k1, qr[d0], p1, 0, 0, 0);
        }
        if (tj >= 4 && tj != 6) {
            const int kpos0 = q0 - 128 + 64 * (tj - 4), qpos = q0w + r32;
#pragma unroll
            for (int r = 0; r < 16; ++r) {
                const int d0 = kpos0 + crow16(r, hi) - qpos, d1 = d0 + 32;
                if (d0 > 128 || d0 < -128) p0[r] = -1e30f;
                if (d1 > 128 || d1 < -128) p1[r] = -1e30f;
            }
        }
        float pmax = p0[0];
#pragma unroll
        for (int r = 1; r < 16; ++r) pmax = fmaxf(pmax, p0[r]);
#pragma unroll
        for (int r = 0; r < 16; ++r) pmax = fmaxf(pmax, p1[r]);
        pmax = fmaxf(pmax, __shfl_xor(pmax, 32));
        const float mn = fmaxf(m_reg, pmax);
        const float alpha = __builtin_amdgcn_exp2f((m_reg - mn) * C);
        m_reg = mn;
        const float mnC = -mn * C;
        float ps = 0.f;
#pragma unroll
        for (int r = 0; r < 16; ++r) { p0[r] = __builtin_amdgcn_exp2f(fmaf(p0[r], C, mnC)); p1[r] = __builtin_amdgcn_exp2f(fmaf(p1[r], C, mnC)); ps += p0[r] + p1[r]; }
        ps += __shfl_xor(ps, 32);
        l_reg = l_reg * alpha + ps;
        if (hi == 0) wsc[r32] = alpha;
        asm volatile("s_waitcnt lgkmcnt(0)" ::: "memory");
#pragma unroll
        for (int r = 0; r < 16; ++r) { const float al = wsc[crow16(r, hi)]; o[0][r] *= al; o[1][r] *= al; }
        bf16x8_t pa[4];
#define PK4A(P, BASE, OUT) do { unsigned a0 = cvtpk_a(P[BASE + 0], P[BASE + 1]), a1 = cvtpk_a(P[BASE + 2], P[BASE + 3]);   \
    unsigned b0 = cvtpk_a(P[BASE + 4], P[BASE + 5]), b1 = cvtpk_a(P[BASE + 6], P[BASE + 7]);                              \
    auto r0 = __builtin_amdgcn_permlane32_swap(a0, b0, false, false); auto r1 = __builtin_amdgcn_permlane32_swap(a1, b1, false, false); \
    u32x4_t w_ = {r0[0], r1[0], r0[1], r1[1]}; OUT = *reinterpret_cast<bf16x8_t*>(&w_); } while (0)
        PK4A(p0, 0, pa[0]); PK4A(p0, 8, pa[1]); PK4A(p1, 0, pa[2]); PK4A(p1, 8, pa[3]);
#undef PK4A
#pragma unroll
        for (int d = 0; d < 2; ++d) {
            const int dd = 32 * d + r32;
#pragma unroll
            for (int ks = 0; ks < 4; ++ks) {
                const bf16x8_t vf = *(const LAS bf16x8_t*)(Vt + dd * PITCH + 16 * ((2 * ks + hi) ^ ((dd >> 3) & 7)));
                o[d] = __builtin_amdgcn_mfma_f32_32x32x16_bf16(pa[ks], vf, o[d], 0, 0, 0);
            }
        }
        if (s == 0) asm volatile("" :: "v"(touch));
        if (s + 1 < nt) { ATTNA_STAGE((s + 1) & 1); if (s + 2 < nt) ATTNA_LOAD(s + 2); }
        __syncthreads();
    }
#undef TILE_KI0
#undef TILE_OF
#undef ATTNA_LOAD
#undef ATTNA_STAGE
    if (hi == 0) wsc[r32] = l_reg;
    asm volatile("s_waitcnt lgkmcnt(0)" ::: "memory");
#pragma unroll
    for (int r = 0; r < 16; ++r) {
        const int orow = crow16(r, hi); const float rl = 1.f / wsc[orow];
        bf16_raw* op = OAB + (size_t)(qrow0 + rowoff + orow) * DM + h * 64 + r32;
        op[0] = f2bf_rne(o[0][r] * rl); op[32] = f2bf_rne(o[1][r] * rl);
    }
}

__device__ __forceinline__ int pos32(int a) { return 8 * ((a & 15) >> 2) + 4 * (a >> 4) + (a & 3); }
__device__ __forceinline__ int act32(int pos) { const int q = pos >> 3, j = pos & 7; return j < 4 ? 4 * q + j : 16 + 4 * q + (j - 4); }
typedef short bf16x8_s __attribute__((ext_vector_type(8)));
typedef float f32x4_s __attribute__((ext_vector_type(4)));
__device__ __forceinline__ unsigned cvtpk_b(float lo, float hi) { return cvtpk_a(lo, hi); }
struct BpPre { u32x4_t st[7]; float cw[4]; float a, bb; };
__device__ __forceinline__ void bprep_fetch(const Params& p, int unit, BpPre& pre) {
    const int tid = opaque_tid(), lane = tid & 63, wave = tid >> 6;
    unsigned char* ws = launder(p.ws);
    const int b = unit / (4 * NCHUNK), h = (unit / NCHUNK) & 3, c = unit % NCHUNK;
    const bool isctx = c < 4;
    const int t0 = isctx ? 64 * c : 64 * (c - 4), tlen = isctx ? CTXL : SEQ;
    const int row0 = isctx ? MLAT + b * CTXL + t0 : b * SEQ + t0;
    const bf16_raw* P = (const bf16_raw*)(ws + WS_P);
#pragma unroll
    for (int it = 0; it < 7; ++it) {
        const int i = tid + NTHREADS * it; pre.st[it] = (u32x4_t){0u, 0u, 0u, 0u};
        if (i < 3264) { const int part = i / 1088, rem = i % 1088, row = rem >> 4, ch = rem & 15, tt = t0 - 2 + row;
            if (tt >= 0 && tt < tlen) pre.st[it] = __builtin_nontemporal_load((const u32x4_t*)(P + (size_t)(row0 - 2 + row) * NAB + 768 + part * 512 + h * 128 + ch * 8)); }
    }
#pragma unroll
    for (int k = 0; k < 4; ++k) { const int i = tid + NTHREADS * k; pre.cw[k] = 0.f;
        if (i < 5 * 384) { const int j = i / 384, rr = i % 384, pp = rr >> 7, ch = rr & 127; pre.cw[k] = p.in[I_CONV][j * 1536 + pp * 512 + h * 128 + ch]; } }
    pre.a = 0.f; pre.bb = 0.f;
    if (wave < 2) { const int d = wave, ti = d ? 63 - lane : lane, row = row0 + ti; const float* AB = (const float*)(ws + WS_AB);
        pre.a = AB[(size_t)row * 16 + d * 4 + h]; pre.bb = AB[(size_t)row * 16 + 8 + d * 4 + h]; }
}
template <int VAR>
__device__ __forceinline__ void bprep_unit(const Params& p, LAS unsigned char* lds, int unit, int next_unit, BpPre& pre) {
    const int tid = opaque_tid(), lane = tid & 63, wave = tid >> 6;
    unsigned char* ws = launder(p.ws);
    const int b = unit / (4 * NCHUNK), h = (unit / NCHUNK) & 3, c = unit % NCHUNK;
    const bool isctx = c < 4;
    const int t0 = isctx ? 64 * c : 64 * (c - 4), tlen = isctx ? CTXL : SEQ;
    const int row0 = isctx ? MLAT + b * CTXL + t0 : b * SEQ + t0;
    constexpr int TP = 272;
    LAS unsigned char* KT = lds; LAS unsigned char* VT = lds + 17408;
    LAS float* AM = (LAS float*)(lds + 34816);
    LAS float* SC = (LAS float*)(lds + 67584);
    LAS unsigned char* QT = lds + 69632; LAS float* Gm = (LAS float*)(lds + 69632 + 17408); LAS float* QKm = (LAS float*)(lds + 69632 + 2 * 17408);
    LAS bf16_raw* XT = (LAS bf16_raw*)(lds + 69632);
    unsigned char* blob0 = ws + (VAR ? WS_H : WS_BLOB) + (size_t)((b * 4 + h) * 2 * NCHUNK + c) * BLOB;
    __syncthreads();
    if (wave < 2) {
        const int d = wave;
        const float a = pre.a, bb = pre.bb;
        const float xx = a + p.in[I_DTB][d * 4 + h];
        const float sp = fmaxf(xx, 0.f) + log1pf(expf(-fabsf(xx)));
        float gc = -expf(p.in[I_ALOG][d * 4 + h]) * sp;
#pragma unroll
        for (int o = 1; o < 64; o <<= 1) { const float y = __shfl_up(gc, o); if (lane >= o) gc += y; }
        SC[d * 64 + lane] = gc; SC[128 + d * 64 + lane] = 1.f / (1.f + expf(-bb)); SC[256 + d * 64 + lane] = expf(gc); SC[384 + d * 64 + lane] = expf(__shfl(gc, 63) - gc);
    }
    LAS float* cwl = (LAS float*)(lds + 136192);
#pragma unroll
    for (int k = 0; k < 4; ++k) { const int i = tid + NTHREADS * k; if (i < 5 * 384) cwl[i] = pre.cw[k]; }
    LAS unsigned char* inp[3] = {lds + 34816, lds + 87040, lds + 105536};
    if (VAR != 4) {
#pragma unroll
        for (int it = 0; it < 7; ++it) {
            const int i = tid + NTHREADS * it;
            if (i < 3264) { const int part = i / 1088, rem = i % 1088, row = rem >> 4, ch = rem & 15; *(LAS u32x4_t*)(inp[part] + row * 272 + ch * 16) = pre.st[it]; }
        }
    }
    __syncthreads();
    if (next_unit >= 0) bprep_fetch(p, next_unit, pre);
    if (VAR != 4) {
        const int tok0 = 8 * wave;
        float acc[3][16];
#pragma unroll
        for (int pp = 0; pp < 3; ++pp) {
            float w[5][2], x[12][2];
#pragma unroll
            for (int j = 0; j < 5; ++j) { const f32x2_t ww = *(const LAS f32x2_t*)(cwl + j * 384 + pp * 128 + 2 * lane); w[j][0] = ww.x; w[j][1] = ww.y; }
#pragma unroll
            for (int r = 0; r < 12; ++r) { const unsigned dd = *(const LAS unsigned*)(inp[pp] + (tok0 + r) * 272 + lane * 4); x[r][0] = __uint_as_float(dd << 16); x[r][1] = __uint_as_float(dd & 0xffff0000u); }
#pragma unroll
            for (int t = 0; t < 8; ++t)
#pragma unroll
                for (int c = 0; c < 2; ++c) { float s = 0.f;
#pragma unroll
                    for (int j = 0; j < 5; ++j) s += w[j][c] * x[t + j][c];
                    acc[pp][2 * t + c] = silu_f(s); }
        }
        float v[16];
#pragma unroll
        for (int t = 0; t < 8; ++t) { v[t] = acc[0][2 * t] * acc[0][2 * t] + acc[0][2 * t + 1] * acc[0][2 * t + 1]; v[8 + t] = acc[1][2 * t] * acc[1][2 * t] + acc[1][2 * t + 1] * acc[1][2 * t + 1]; }
#define BFLY(H, MASK) do { const bool up_ = (lane & (MASK)) != 0; _Pragma("unroll") for (int i = 0; i < (H); ++i) { const float send_ = up_ ? v[i] : v[i + (H)], keep_ = up_ ? v[i + (H)] : v[i]; v[i] = keep_ + __shfl_xor(send_, (MASK)); } } while (0)
        BFLY(8, 32); BFLY(4, 16); BFLY(2, 8); BFLY(1, 4);
#undef BFLY
        float tot = v[0]; tot += __shfl_xor(tot, 1); tot += __shfl_xor(tot, 2);
        LAS float* wred = (LAS float*)(lds + 143872) + wave * 16;
        if ((lane & 3) == 0) wred[(lane >> 2) & 15] = tot;
        float rn[16];
#pragma unroll
        for (int i = 0; i < 4; ++i) { const f32x4_t r4 = *(const LAS f32x4_t*)(wred + 4 * i); rn[4 * i] = r4.x; rn[4 * i + 1] = r4.y; rn[4 * i + 2] = r4.z; rn[4 * i + 3] = r4.w; }
#pragma unroll
        for (int t = 0; t < 8; ++t) {
            const float rq = rsqrtf(rn[t] + EPS) * 0.08838834764831845f, rk = rsqrtf(rn[8 + t] + EPS);
            *(LAS unsigned*)(QT + (tok0 + t) * TP + lane * 4) = pk2(acc[0][2 * t] * rq, acc[0][2 * t + 1] * rq);
            *(LAS unsigned*)(KT + (tok0 + t) * TP + lane * 4) = pk2(acc[1][2 * t] * rk, acc[1][2 * t + 1] * rk);
            *(LAS unsigned*)(VT + (tok0 + t) * TP + lane * 4) = pk2(acc[2][2 * t], acc[2][2 * t + 1]);
        }
    }
    __syncthreads();
#pragma unroll
    for (int which = 0; which < 2; ++which) {
        LAS unsigned char* X = which ? QT : KT; LAS float* M = which ? QKm : Gm;
#pragma unroll
        for (int tt = 0; tt < 2; ++tt) {
            const int ti = 2 * wave + tt, mt = ti >> 2, nt = ti & 3;
            f32x4_s acc = {0.f, 0.f, 0.f, 0.f};
#pragma unroll
            for (int ks = 0; ks < 4; ++ks) {
                const bf16x8_s a = *(const LAS bf16x8_s*)(X + (16 * mt + (lane & 15)) * TP + 64 * ks + 16 * (lane >> 4));
                const bf16x8_s bq = *(const LAS bf16x8_s*)(KT + (16 * nt + (lane & 15)) * TP + 64 * ks + 16 * (lane >> 4));
                acc = __builtin_amdgcn_mfma_f32_16x16x32_bf16(a, bq, acc, 0, 0, 0);
            }
#pragma unroll
            for (int i = 0; i < 4; ++i) M[(16 * mt + 4 * (lane >> 4) + i) * 68 + 16 * nt + (lane & 15)] = acc[i];
        }
    }
    __syncthreads();
    {
        const int d = tid >> 8, r = tid & 255, pp = r >> 2, jb = (r & 3) * 16, tip = d ? 63 - pp : pp;
        const float bp = SC[128 + d * 64 + pp], gp = SC[d * 64 + pp];
#pragma unroll
        for (int e4 = 0; e4 < 4; ++e4) {
            float v[4];
#pragma unroll
            for (int e = 0; e < 4; ++e) { const int j2 = jb + 4 * e4 + e, tj2 = d ? 63 - j2 : j2;
                v[e] = (j2 < pp) ? bp * Gm[tip * 68 + tj2] * __expf(gp - SC[d * 64 + j2]) : 0.f; }
            *(LAS f32x4_t*)(AM + (d * 64 + pp) * 64 + jb + 4 * e4) = (f32x4_t){v[0], v[1], v[2], v[3]};
        }
    }
    if (VAR != 3) {
#pragma unroll
    for (int it = 0; it < 2; ++it) {
        const int id = tid + 512 * it, d = id >> 9, pp = (id >> 3) & 63, chn = id & 7, tip = d ? 63 - pp : pp;
        const float gp = SC[d * 64 + pp]; float v[8];
#pragma unroll
        for (int j = 0; j < 8; ++j) { const int p2 = 32 * (chn >> 2) + act32(8 * (chn & 3) + j), ti2 = d ? 63 - p2 : p2;
            v[j] = (p2 <= pp) ? QKm[tip * 68 + ti2] * __expf(gp - SC[d * 64 + p2]) : 0.f; }
        *(u32x4_t*)(blob0 + (size_t)d * NCHUNK * BLOB + BL_AQK + pp * 128 + chn * 16) = pack8(v);
    }
#pragma unroll
    for (int it = 0; it < 4; ++it) {
        const int id = tid + 512 * it, d = id >> 10, pp = (id >> 4) & 63, chn = id & 15, tip = d ? 63 - pp : pp;
        const float eg = SC[256 + d * 64 + pp]; float v[8];
        const LAS bf16_raw* qrow = (const LAS bf16_raw*)(QT + tip * TP) + 32 * (chn >> 2) + 4 * (chn & 3);
#pragma unroll
        for (int j = 0; j < 2; ++j) { const u32x2_t qq = *(const LAS u32x2_t*)(qrow + 16 * j);
            v[4 * j] = bf2f(qq.x & 0xffffu) * eg; v[4 * j + 1] = __uint_as_float(qq.x & 0xffff0000u) * eg; v[4 * j + 2] = bf2f(qq.y & 0xffffu) * eg; v[4 * j + 3] = __uint_as_float(qq.y & 0xffff0000u) * eg; }
        *(u32x4_t*)(blob0 + (size_t)d * NCHUNK * BLOB + BL_QG + pp * 256 + chn * 16) = pack8(v);
    }
#pragma unroll
    for (int it = 0; it < 4; ++it) {
        const int id = tid + 512 * it, d = id >> 10, dk = (id >> 3) & 127, chn = id & 7;
        float v[8];
#pragma unroll
        for (int j = 0; j < 8; ++j) { const int p2 = 32 * (chn >> 2) + act32(8 * (chn & 3) + j), ti2 = d ? 63 - p2 : p2;
            v[j] = bf2f(((const LAS bf16_raw*)(KT + ti2 * TP))[dk]) * SC[384 + d * 64 + p2]; }
        *(u32x4_t*)(blob0 + (size_t)d * NCHUNK * BLOB + BL_KDT + dk * 128 + chn * 16) = pack8(v);
    }
    }
    if ((tid & 255) == 0) { const int d = tid >> 8; *(float*)(blob0 + (size_t)d * NCHUNK * BLOB + BL_GE) = SC[256 + d * 64 + 63]; }
    __syncthreads();
    LAS float* DM = (LAS float*)(lds + 69632 + 32768);
    if (VAR != 2) {
    if (tid < 128) {
        const int d = tid >> 6, blk = (tid >> 4) & 3, colj = tid & 15;
        const LAS float* Ab = AM + (d * 64 + 16 * blk) * 64 + 16 * blk;
        float y[16];
#pragma unroll
        for (int r = 0; r < 16; ++r) {
            float acc = (r == colj) ? 1.f : 0.f;
#pragma unroll
            for (int s2 = 0; s2 < r; ++s2) acc -= Ab[r * 64 + s2] * y[s2];
            y[r] = acc;
        }
#pragma unroll
        for (int r = 0; r < 16; ++r) DM[((d * 4 + blk) * 16 + r) * 16 + colj] = y[r];
    }
    __syncthreads();
    {
        const int d = wave >> 2, w4 = wave & 3, l15 = lane & 15, q = lane >> 4;
        bf16x8_s fa10, fa2, fa3a, fa3b, fd[4];
#define BLK4(i_, j_) (*(const LAS f32x4_t*)(AM + (d * 64 + 16 * (i_) + l15) * 64 + 16 * (j_) + 4 * q))
#define MKFRAG(OUT, LO, HI, SGN) do { u32x4_t w_; w_.x = cvtpk_b(SGN LO.x, SGN LO.y); w_.y = cvtpk_b(SGN LO.z, SGN LO.w); w_.z = cvtpk_b(SGN HI.x, SGN HI.y); w_.w = cvtpk_b(SGN HI.z, SGN HI.w); OUT = *reinterpret_cast<bf16x8_s*>(&w_); } while (0)
        const f32x4_t zero4 = {0.f, 0.f, 0.f, 0.f};
        { const f32x4_t a = BLK4(1, 0); MKFRAG(fa10, a, zero4, -); }
        { const f32x4_t a = BLK4(2, 0), b2 = BLK4(2, 1); MKFRAG(fa2, a, b2, -); }
        { const f32x4_t a = BLK4(3, 0), b2 = BLK4(3, 1); MKFRAG(fa3a, a, b2, -); }
        { const f32x4_t a = BLK4(3, 2); MKFRAG(fa3b, a, zero4, -); }
#pragma unroll
        for (int i = 0; i < 4; ++i) { const f32x4_t dd = *(const LAS f32x4_t*)(DM + ((d * 4 + i) * 16 + l15) * 16 + 4 * q); MKFRAG(fd[i], dd, zero4, +); }
#undef BLK4
        float rsc[16];
#pragma unroll
        for (int k = 0; k < 16; ++k) { const int pp = 16 * (k >> 2) + 4 * q + (k & 3); rsc[k] = SC[128 + d * 64 + pp] * (w4 >= 2 ? SC[256 + d * 64 + pp] : 1.f); }
#pragma unroll
        for (int tt = 0; tt < 4; ++tt) {
            const int nt = 4 * w4 + tt;
            const bool isw = nt >= 8;
            const LAS bf16_raw* colp = (isw ? (const LAS bf16_raw*)KT + 16 * (nt - 8) : (const LAS bf16_raw*)VT + 16 * nt) + l15;
            f32x4_s R[4];
#pragma unroll
            for (int i = 0; i < 4; ++i)
#pragma unroll
                for (int e = 0; e < 4; ++e) { const int pp = 16 * i + 4 * q + e, tip = d ? 63 - pp : pp; R[i][e] = rsc[4 * i + e] * bf2f(colp[tip * (TP / 2)]); }
            f32x4_s X[4]; bf16x8_s xb01, xb2;
            const f32x4_s z4 = {0.f, 0.f, 0.f, 0.f};
#define ACC2B(OUT, LO, HI) do { u32x4_t w_; w_.x = cvtpk_b(LO[0], LO[1]); w_.y = cvtpk_b(LO[2], LO[3]); w_.z = cvtpk_b(HI[0], HI[1]); w_.w = cvtpk_b(HI[2], HI[3]); OUT = *reinterpret_cast<bf16x8_s*>(&w_); } while (0)
            bf16x8_s yb;
            ACC2B(yb, R[0], z4); X[0] = __builtin_amdgcn_mfma_f32_16x16x32_bf16(fd[0], yb, z4, 0, 0, 0);
            { bf16x8_s xb0; ACC2B(xb0, X[0], z4); f32x4_s y1 = __builtin_amdgcn_mfma_f32_16x16x32_bf16(fa10, xb0, R[1], 0, 0, 0);
              ACC2B(yb, y1, z4); X[1] = __builtin_amdgcn_mfma_f32_16x16x32_bf16(fd[1], yb, z4, 0, 0, 0); }
            ACC2B(xb01, X[0], X[1]);
            { f32x4_s y2 = __builtin_amdgcn_mfma_f32_16x16x32_bf16(fa2, xb01, R[2], 0, 0, 0);
              ACC2B(yb, y2, z4); X[2] = __builtin_amdgcn_mfma_f32_16x16x32_bf16(fd[2], yb, z4, 0, 0, 0); }
            ACC2B(xb2, X[2], z4);
            { f32x4_s y3 = __builtin_amdgcn_mfma_f32_16x16x32_bf16(fa3a, xb01, R[3], 0, 0, 0); y3 = __builtin_amdgcn_mfma_f32_16x16x32_bf16(fa3b, xb2, y3, 0, 0, 0);
              ACC2B(yb, y3, z4); X[3] = __builtin_amdgcn_mfma_f32_16x16x32_bf16(fd[3], yb, z4, 0, 0, 0); }
#undef ACC2B
            if (!isw) {
                u32x4_t w0, w1;
                w0.x = cvtpk_b(X[0][0], X[0][1]); w0.y = cvtpk_b(X[0][2], X[0][3]); w0.z = cvtpk_b(X[1][0], X[1][1]); w0.w = cvtpk_b(X[1][2], X[1][3]);
                w1.x = cvtpk_b(X[2][0], X[2][1]); w1.y = cvtpk_b(X[2][2], X[2][3]); w1.z = cvtpk_b(X[3][0], X[3][1]); w1.w = cvtpk_b(X[3][2], X[3][3]);
                unsigned char* dst = blob0 + (size_t)d * NCHUNK * BLOB + BL_U + (nt * 64 + lane) * 32;
                *(u32x4_t*)dst = w0; *(u32x4_t*)(dst + 16) = w1;
            } else {
                const int dk = 16 * (nt - 8) + l15; LAS bf16_raw* xt = XT + d * 8192 + (dk & ~31) + pos32(dk & 31);
#pragma unroll
                for (int i = 0; i < 4; ++i)
#pragma unroll
                    for (int e = 0; e < 4; ++e) xt[(16 * i + 4 * q + e) * 128] = f2bf_rne(-X[i][e]);
            }
        }
#undef MKFRAG
    }
    }
    __syncthreads();
#pragma unroll
    for (int it = 0; it < 4; ++it) {
        const int id = tid + 512 * it, d = id >> 10, r = id & 1023;
        *(u32x4_t*)(blob0 + (size_t)d * NCHUNK * BLOB + BL_WN + r * 16) = *(const LAS u32x4_t*)(XT + d * 8192 + r * 8);
    }
}
__device__ __forceinline__ void phase_bprep(const Params& p, LAS unsigned char* lds) {
    constexpr int NU = 2 * 4 * NCHUNK; const int G = gridDim.x;
    BpPre pre;
    if ((int)blockIdx.x < NU) bprep_fetch(p, blockIdx.x, pre);
    for (int u = blockIdx.x; u < NU; u += G) bprep_unit<0>(p, lds, u, u + G < NU ? u + G : -1, pre);
    if (PROBE >= 31 && PROBE <= 34) { if ((int)blockIdx.x < NU) bprep_fetch(p, blockIdx.x, pre);
        for (int u = blockIdx.x; u < NU; u += G) bprep_unit<PROBE - 30 < 0 ? 0 : (PROBE >= 31 && PROBE <= 34 ? PROBE - 30 : 0)>(p, lds, u, u + G < NU ? u + G : -1, pre); }
}

constexpr int SCAN_NSPLIT = 8;
constexpr int SCAN_NCW = 8 / SCAN_NSPLIT;
static_assert((SCAN_NSPLIT == 4 || SCAN_NSPLIT == 8) && NCHUNK % 6 == 0, "scan split");
template <int VAR>
__device__ __forceinline__ void scan_chain(const Params& p, LAS unsigned char* lds, int chain, int half) {
    const int tid = opaque_tid(), lane = tid & 63, wave = __builtin_amdgcn_readfirstlane(tid >> 6);
    unsigned char* ws = launder(p.ws);
    const int b = chain >> 3, dir = (chain >> 2) & 1, h = chain & 3;
    const unsigned char* blobs = ws + WS_BLOB + (size_t)(((b * 4 + h) * 2 + dir) * NCHUNK) * BLOB;
    unsigned char* snaps = ws + WS_SNAP + (size_t)(((b * 4 + h) * 2 + dir) * NCHUNK) * SNAP;
    constexpr int BUF = 44032, O_WN = 0, O_KDT = 17408, O_U = 35840, O_GE = 2 * BUF, O_SNP = 2 * BUF + 1024;
#define SCAN_CHUNK(n) (VAR == 1 ? 0 : (dir == 0 ? (n) : ((n) < 4 ? 3 - (n) : 135 - (n))))
    __syncthreads();
    if (wave >= 4) {
        const int lt = tid - 256;
        u32x4_t r0[9], r1[9], r2[9], r3[9], r4[9], r5[9];
#define SCAN_LOAD(R, n) do { { const int nn_ = (n) < NCHUNK ? (n) : NCHUNK - 1; const unsigned char* src = blobs + (size_t)SCAN_CHUNK(nn_) * BLOB + lt * 16;     \
            _Pragma("unroll") for (int i = 0; i < 4; ++i) { R[i] = *(const u32x4_t*)(src + BL_WN + i * 4096); R[4 + i] = *(const u32x4_t*)(src + BL_KDT + i * 4096); } \
            if (SCAN_NCW == 2) R[8] = *(const u32x4_t*)(src + BL_U + half * 4096); \
            else if (lt < 128) R[8] = *(const u32x4_t*)(src + BL_U + half * 2048); } } while (0)
#define SCAN_WRITE(bufi, R) do { LAS unsigned char* dst = lds + (bufi) * BUF; _Pragma("unroll") for (int i = 0; i < 4; ++i) { const int g = lt + 256 * i; \
            *(LAS u32x4_t*)(dst + O_WN + (g >> 4) * 272 + (g & 15) * 16) = R[i]; *(LAS u32x4_t*)(dst + O_KDT + (g >> 3) * 144 + (g & 7) * 16) = R[4 + i]; } \
            if (SCAN_NCW > 1 || lt < 128) *(LAS u32x4_t*)(dst + O_U + lt * 16) = R[8]; } while (0)
        if (lt < NCHUNK) ((LAS float*)(lds + O_GE))[lt] = *(const float*)(blobs + (size_t)SCAN_CHUNK(lt) * BLOB + BL_GE);
        SCAN_LOAD(r0, 0); SCAN_LOAD(r1, 1); SCAN_LOAD(r2, 2); SCAN_LOAD(r3, 3); SCAN_LOAD(r4, 4); SCAN_LOAD(r5, 5);
        SCAN_WRITE(0, r0); SCAN_LOAD(r0, 6);
        __syncthreads();
        for (int n = 0; n < NCHUNK; n += 6) {
            SCAN_WRITE(1, r1); SCAN_LOAD(r1, n + 7); __syncthreads();
            SCAN_WRITE(0, r2); SCAN_LOAD(r2, n + 8); __syncthreads();
            SCAN_WRITE(1, r3); SCAN_LOAD(r3, n + 9); __syncthreads();
            SCAN_WRITE(0, r4); SCAN_LOAD(r4, n + 10); __syncthreads();
            SCAN_WRITE(1, r5); SCAN_LOAD(r5, n + 11); __syncthreads();
            SCAN_WRITE(0, r0); SCAN_LOAD(r0, n + 12); __syncthreads();
        }
#undef SCAN_LOAD
#undef SCAN_WRITE
    } else if (wave >= SCAN_NCW) {
        constexpr int NH = 4 - SCAN_NCW, NF = 6 * SCAN_NCW / NH;
        __syncthreads();
        for (int n = 0; n < NCHUNK; ++n) {
            __syncthreads();
            if (VAR == 0 || VAR == 3) {
                const LAS unsigned char* stg = lds + O_SNP + (n & 1) * (6144 * SCAN_NCW) + lane * 16;
                unsigned char* snap = snaps + (size_t)(VAR == 3 ? (n & 1) : n) * SNAP + lane * 16;
                u32x4_t t[NF];
#pragma unroll
                for (int j = 0; j < NF; ++j) t[j] = *(const LAS u32x4_t*)(stg + ((wave - SCAN_NCW) + NH * j) * 1024);
#pragma unroll
                for (int j = 0; j < NF; ++j) { const int F = (wave - SCAN_NCW) + NH * j, cw = F / 6, f = F % 6;
                    *(u32x4_t*)(snap + (f < 4 ? f * 8192 : 32768 + (f - 4) * 8192) + (half * SCAN_NCW + cw) * 1024) = t[j]; }
            }
        }
    } else {
        const int slice = half * SCAN_NCW + wave, l15 = lane & 15, q = lane >> 4;
        f32x4_s S[8];
#pragma unroll
        for (int m = 0; m < 8; ++m) S[m] = (f32x4_s){0.f, 0.f, 0.f, 0.f};
        const int aoff272 = l15 * 272 + 16 * q, aoff144 = l15 * 144 + 16 * q;
        __syncthreads();
        for (int n = 0; n < NCHUNK; ++n) {
            LAS unsigned char* buf = lds + (n & 1) * BUF;
            const u32x4_t u0 = *(const LAS u32x4_t*)(buf + O_U + (wave * 64 + lane) * 32), u1 = *(const LAS u32x4_t*)(buf + O_U + (wave * 64 + lane) * 32 + 16);
            const float ge = ((const LAS float*)(lds + O_GE))[n];
            bf16x8_s fa[16], fb[16];
#pragma unroll
            for (int ks = 0; ks < 4; ++ks)
#pragma unroll
                for (int m = 0; m < 4; ++m) fa[m * 4 + ks] = *(const LAS bf16x8_s*)(buf + O_WN + m * 16 * 272 + aoff272 + 64 * ks);
#pragma unroll
            for (int ks = 0; ks < 2; ++ks)
#pragma unroll
                for (int m = 0; m < 8; ++m) fb[m * 2 + ks] = *(const LAS bf16x8_s*)(buf + O_KDT + m * 16 * 144 + aoff144 + 64 * ks);
            __builtin_amdgcn_sched_barrier(0);
            u32x4_t sbw[4];
#pragma unroll
            for (int ks = 0; ks < 4; ++ks) { sbw[ks].x = cvtpk_b(S[2 * ks][0], S[2 * ks][1]); sbw[ks].y = cvtpk_b(S[2 * ks][2], S[2 * ks][3]); sbw[ks].z = cvtpk_b(S[2 * ks + 1][0], S[2 * ks + 1][1]); sbw[ks].w = cvtpk_b(S[2 * ks + 1][2], S[2 * ks + 1][3]); }
            LAS unsigned char* stg = lds + O_SNP + (n & 1) * (6144 * SCAN_NCW) + wave * 6144 + lane * 16;
#pragma unroll
            for (int ks = 0; ks < 4; ++ks) *(LAS u32x4_t*)(stg + ks * 1024) = sbw[ks];
            f32x4_s vn[4];
            { float uu[16]; unpack8(u0, uu); unpack8(u1, uu + 8);
#pragma unroll
              for (int m = 0; m < 4; ++m) vn[m] = (f32x4_s){uu[4 * m], uu[4 * m + 1], uu[4 * m + 2], uu[4 * m + 3]}; }
            __builtin_amdgcn_sched_barrier(0);
#pragma unroll
            for (int ks = 0; ks < 4; ++ks)
#pragma unroll
                for (int m = 0; m < 4; ++m) {
                    vn[m] = __builtin_amdgcn_mfma_f32_16x16x32_bf16(fa[m * 4 + ks], *reinterpret_cast<bf16x8_s*>(&sbw[ks]), vn[m], 0, 0, 0);
                    if (ks * 4 + m < 8) S[ks * 4 + m] = S[ks * 4 + m] * ge;
                }
            __builtin_amdgcn_sched_barrier(0);
            u32x4_t vbw[2];
#pragma unroll
            for (int ks = 0; ks < 2; ++ks) { vbw[ks].x = cvtpk_b(vn[2 * ks][0], vn[2 * ks][1]); vbw[ks].y = cvtpk_b(vn[2 * ks][2], vn[2 * ks][3]); vbw[ks].z = cvtpk_b(vn[2 * ks + 1][0], vn[2 * ks + 1][1]); vbw[ks].w = cvtpk_b(vn[2 * ks + 1][2], vn[2 * ks + 1][3]); }
#pragma unroll
            for (int ks = 0; ks < 2; ++ks)
#pragma unroll
                for (int m = 0; m < 8; ++m) S[m] = __builtin_amdgcn_mfma_f32_16x16x32_bf16(fb[m * 2 + ks], *reinterpret_cast<bf16x8_s*>(&vbw[ks]), S[m], 0, 0, 0);
#pragma unroll
            for (int ks = 0; ks < 2; ++ks) *(LAS u32x4_t*)(stg + (4 + ks) * 1024) = vbw[ks];
            __syncthreads();
        }
    }
#undef SCAN_CHUNK
}

__device__ __forceinline__ void outgate_item(const Params& p, LAS unsigned char* lds, int item) {
    const int tid = opaque_tid(), lane = tid & 63, wave = tid >> 6, l15 = lane & 15, q = lane >> 4;
    unsigned char* ws = launder(p.ws);
    const int b = item / (4 * NCHUNK), h = (item / NCHUNK) & 3, c = item % NCHUNK;
    LAS float* obt = (LAS float*)lds;
    LAS float* sq = (LAS float*)(lds + 64 * 132 * 4);
    LAS unsigned char* At = lds + 36864;
    f32x4_s o[2][4];
    const int rowbase = c < 4 ? MLAT + b * CTXL + 64 * c : b * SEQ + 64 * (c - 4);
    const bf16_raw* Pz = (const bf16_raw*)(ws + WS_P) + (size_t)rowbase * NAB + 2304 + h * 128 + 16 * wave + l15;
    bf16_raw zr[16];
#pragma unroll
    for (int m = 0; m < 4; ++m)
#pragma unroll
        for (int i = 0; i < 4; ++i) zr[4 * m + i] = Pz[(size_t)(16 * m + 4 * q + i) * NAB];
    bf16x8_s sb[2][4], vb[2][2];
    {
        u32x4_t ra[2][3];
#pragma unroll
        for (int d = 0; d < 2; ++d) {
            const int nstep = d == 0 ? c : (c < 4 ? 3 - c : 135 - c);
            const unsigned char* blob = ws + WS_BLOB + (size_t)(((b * 4 + h) * 2 + d) * NCHUNK + c) * BLOB;
            const unsigned char* snap = ws + WS_SNAP + (size_t)(((b * 4 + h) * 2 + d) * NCHUNK + nstep) * SNAP + (wave * 64 + lane) * 16;
            ra[d][0] = __builtin_nontemporal_load((const u32x4_t*)(blob + BL_QG + tid * 16)); ra[d][1] = __builtin_nontemporal_load((const u32x4_t*)(blob + BL_QG + (tid + 512) * 16)); ra[d][2] = __builtin_nontemporal_load((const u32x4_t*)(blob + BL_AQK + tid * 16));
#pragma unroll
            for (int ks = 0; ks < 4; ++ks) sb[d][ks] = __builtin_nontemporal_load((const bf16x8_s*)(snap + ks * 8192));
#pragma unroll
            for (int ks = 0; ks < 2; ++ks) vb[d][ks] = __builtin_nontemporal_load((const bf16x8_s*)(snap + 32768 + ks * 8192));
        }
        __syncthreads();
#pragma unroll
        for (int d = 0; d < 2; ++d) {
            LAS unsigned char* Ad = At + d * 26624;
            *(LAS u32x4_t*)(Ad + (tid >> 4) * 272 + (tid & 15) * 16) = ra[d][0]; *(LAS u32x4_t*)(Ad + ((tid + 512) >> 4) * 272 + (tid & 15) * 16) = ra[d][1];
            *(LAS u32x4_t*)(Ad + 17408 + (tid >> 3) * 144 + (tid & 7) * 16) = ra[d][2];
        }
    }
    __syncthreads();
#pragma unroll
    for (int d = 0; d < 2; ++d) {
        const LAS unsigned char* Ad = At + d * 26624;
        bf16x8_s aq[16], aa[8];
#pragma unroll
        for (int m = 0; m < 4; ++m) {
#pragma unroll
            for (int ks = 0; ks < 4; ++ks) aq[4 * m + ks] = *(const LAS bf16x8_s*)(Ad + (16 * m + l15) * 272 + 64 * ks + 16 * q);
#pragma unroll
            for (int ks = 0; ks < 2; ++ks) aa[2 * m + ks] = *(const LAS bf16x8_s*)(Ad + 17408 + (16 * m + l15) * 144 + 64 * ks + 16 * q);
        }
        __builtin_amdgcn_sched_barrier(0);
#pragma unroll
        for (int m = 0; m < 4; ++m) o[d][m] = (f32x4_s){0.f, 0.f, 0.f, 0.f};
#pragma unroll
        for (int ks = 0; ks < 4; ++ks)
#pragma unroll
            for (int m = 0; m < 4; ++m) o[d][m] = __builtin_amdgcn_mfma_f32_16x16x32_bf16(aq[4 * m + ks], sb[d][ks], o[d][m], 0, 0, 0);
#pragma unroll
        for (int ks = 0; ks < 2; ++ks)
#pragma unroll
            for (int m = 0; m < 4; ++m) o[d][m] = __builtin_amdgcn_mfma_f32_16x16x32_bf16(aa[2 * m + ks], vb[d][ks], o[d][m], 0, 0, 0);
        __builtin_amdgcn_sched_barrier(0);
    }
    __syncthreads();
#pragma unroll
    for (int m = 0; m < 4; ++m)
#pragma unroll
        for (int i = 0; i < 4; ++i) obt[(16 * m + 4 * q + i) * 132 + 16 * wave + l15] = o[1][m][i];
    __syncthreads();
    float x[16], ssq[16];
#pragma unroll
    for (int m = 0; m < 4; ++m)
#pragma unroll
        for (int i = 0; i < 4; ++i) { const int pp = 16 * m + 4 * q + i; const float v = o[0][m][i] + obt[(63 - pp) * 132 + 16 * wave + l15]; x[4 * m + i] = v; ssq[4 * m + i] = v * v; }
#pragma unroll
    for (int k = 0; k < 16; ++k) { float t = ssq[k]; t += __shfl_xor(t, 1); t += __shfl_xor(t, 2); t += __shfl_xor(t, 4); t += __shfl_xor(t, 8); ssq[k] = t; }
    if (l15 == 0) {
#pragma unroll
        for (int m = 0; m < 4; ++m)
#pragma unroll
            for (int i = 0; i < 4; ++i) sq[wave * 64 + 16 * m + 4 * q + i] = ssq[4 * m + i];
    }
    __syncthreads();
    bf16_raw* OAB = (bf16_raw*)(ws + WS_OAB);
    const int col = h * 128 + 16 * wave + l15; const float on = p.in[I_ONORM][16 * wave + l15];
#pragma unroll
    for (int m = 0; m < 4; ++m)
#pragma unroll
        for (int i = 0; i < 4; ++i) {
            const int pp = 16 * m + 4 * q + i;
            float t = 0.f;
#pragma unroll
            for (int w = 0; w < 8; ++w) t += sq[w * 64 + pp];
            const float rms = rsqrtf(t * (1.f / 128.f) + EPS);
            const size_t row = (size_t)(rowbase + pp);
            const float z = bf2f(zr[4 * m + i]);
            OAB[row * DM + 512 + col] = f2bf_rne(x[4 * m + i] * rms * on * silu_f(z));
        }
}
__device__ __forceinline__ void phase_outgate(const Params& p, LAS unsigned char* lds) {
    for (int it = blockIdx.x; it < 2 * 4 * NCHUNK; it += gridDim.x) outgate_item(p, lds, it);
}

__device__ __forceinline__ void mini_resid_tile(const bf16_raw* A, const bf16_raw* Bt, const float* res, const float* gate, float* out, int row0, int col0, LAS unsigned char* lds) {
    const int tid = opaque_tid(), lane = tid & 63, wave = tid >> 6, l15 = lane & 15, q = lane >> 4;
    const bf16_raw* ap = A + (size_t)(row0 + l15) * DM + 128 * wave + 8 * q;
    const bf16_raw* bp = Bt + (size_t)(col0 + l15) * DM + 128 * wave + 8 * q;
    bf16x8_s af[4][4], bfr[2][4];
#pragma unroll
    for (int j = 0; j < 4; ++j) {
#pragma unroll
        for (int rt = 0; rt < 4; ++rt) af[rt][j] = *(const bf16x8_s*)(ap + (size_t)(16 * rt) * DM + 32 * j);
#pragma unroll
        for (int c = 0; c < 2; ++c) bfr[c][j] = *(const bf16x8_s*)(bp + (size_t)(16 * c) * DM + 32 * j);
    }
    f32x4_s acc[4][2];
#pragma unroll
    for (int rt = 0; rt < 4; ++rt) { acc[rt][0] = (f32x4_s){0.f, 0.f, 0.f, 0.f}; acc[rt][1] = (f32x4_s){0.f, 0.f, 0.f, 0.f}; }
#pragma unroll
    for (int j = 0; j < 4; ++j)
#pragma unroll
        for (int rt = 0; rt < 4; ++rt)
#pragma unroll
            for (int c = 0; c < 2; ++c) acc[rt][c] = __builtin_amdgcn_mfma_f32_16x16x32_bf16(af[rt][j], bfr[c][j], acc[rt][c], 0, 0, 0);
    LAS f32x4_s* red = (LAS f32x4_s*)lds;
    __syncthreads();
#pragma unroll
    for (int rt = 0; rt < 4; ++rt)
#pragma unroll
        for (int c = 0; c < 2; ++c) red[(wave * 8 + rt * 2 + c) * 64 + lane] = acc[rt][c];
    __syncthreads();
    f32x4_s s = red[wave * 64 + lane];
#pragma unroll
    for (int w = 1; w < 8; ++w) s += red[(w * 8 + wave) * 64 + lane];
    const int r0 = row0 + 16 * (wave >> 1), c = col0 + 16 * (wave & 1) + l15; const float gv = gate[c];
#pragma unroll
    for (int i = 0; i < 4; ++i) { const size_t o = (size_t)(r0 + 4 * q + i) * DM + c; out[o] = res[o] + gv * s[i]; }
}

__device__ __forceinline__ void moe2_ctx_piece(const bf16_raw* HIDe, const bf16_raw* W2e  , const float* GATEe, bf16_raw* YEe, int ct, LAS unsigned char* lds) {
    const int tid = opaque_tid(), lane = tid & 63, wave = tid >> 6, l15 = lane & 15, q = lane >> 4;
    const bf16_raw* ap = HIDe + (size_t)(2 * CAPL + l15) * FF + 256 * wave + 8 * q;
    const bf16_raw* bp = W2e + (size_t)(32 * ct + l15) * FF + 256 * wave + 8 * q;
    f32x4_s acc[4][2];
#pragma unroll
    for (int rt = 0; rt < 4; ++rt) { acc[rt][0] = (f32x4_s){0.f, 0.f, 0.f, 0.f}; acc[rt][1] = (f32x4_s){0.f, 0.f, 0.f, 0.f}; }
#pragma unroll
    for (int hf = 0; hf < 2; ++hf) {
        bf16x8_s af[4][4], bfr[2][4];
#pragma unroll
        for (int j = 0; j < 4; ++j) {
#pragma unroll
            for (int rt = 0; rt < 4; ++rt) af[rt][j] = *(const bf16x8_s*)(ap + (size_t)(16 * rt) * FF + 128 * hf + 32 * j);
#pragma unroll
            for (int c = 0; c < 2; ++c) bfr[c][j] = *(const bf16x8_s*)(bp + (size_t)(16 * c) * FF + 128 * hf + 32 * j);
        }
        __builtin_amdgcn_sched_barrier(0);
#pragma unroll
        for (int j = 0; j < 4; ++j)
#pragma unroll
            for (int rt = 0; rt < 4; ++rt)
#pragma unroll
                for (int c = 0; c < 2; ++c) acc[rt][c] = __builtin_amdgcn_mfma_f32_16x16x32_bf16(af[rt][j], bfr[c][j], acc[rt][c], 0, 0, 0);
        __builtin_amdgcn_sched_barrier(0);
    }
    LAS f32x4_s* red = (LAS f32x4_s*)lds;
    __syncthreads();
#pragma unroll
    for (int rt = 0; rt < 4; ++rt)
#pragma unroll
        for (int c = 0; c < 2; ++c) red[(wave * 8 + rt * 2 + c) * 64 + lane] = acc[rt][c];
    __syncthreads();
    f32x4_s s = red[wave * 64 + lane];
#pragma unroll
    for (int w = 1; w < 8; ++w) s += red[(w * 8 + wave) * 64 + lane];
    const int rt = wave >> 1, c = wave & 1;
#pragma unroll
    for (int i = 0; i < 4; ++i) { const int r = 2 * CAPL + 16 * rt + 4 * q + i; YEe[(size_t)r * DM + 32 * ct + 16 * c + l15] = f2bf_rne(s[i] * GATEe[r]); }
}

__device__ __forceinline__ int block_excl_scan(int v, LAS int* tmp, int tid) {
    const int lane = tid & 63, w = tid >> 6; int x = v;
#pragma unroll
    for (int o = 1; o < 64; o <<= 1) { const int y = __shfl_up(x, o); if (lane >= o) x += y; }
    __syncthreads();
    if (lane == 63) tmp[w] = x;
    __syncthreads();
    int off = 0;
    for (int i = 0; i < w; ++i) off += tmp[i];
    return off + x - v;
}
__device__ __forceinline__ void topk_select(const float* aff, int n, int cap, int e, int slot0, int row0, int* IDX, float* GATE, int* INV, LAS unsigned char* lds) {
    const int tid = opaque_tid();
    LAS unsigned* sv = (LAS unsigned*)lds; LAS unsigned* hist = sv + 8192; LAS int* misc = (LAS int*)(hist + 256); LAS int* tmp = misc + 16;
    __syncthreads();
    {
        f32x4_t ld[4];
#pragma unroll
        for (int k = 0; k < 4; ++k) { const int i4 = tid + NTHREADS * k; ld[k] = (f32x4_t){0.f, 0.f, 0.f, 0.f}; if (4 * i4 < n) ld[k] = __builtin_nontemporal_load((const f32x4_t*)(aff + 4 * i4)); }
#pragma unroll
        for (int k = 0; k < 4; ++k) { const int i4 = tid + NTHREADS * k; if (4 * i4 < n) *(LAS f32x4_t*)((LAS float*)sv + 4 * i4) = ld[k]; }
    }
    unsigned prefix = 0u, mask = 0u; int kth = cap;
    for (int pass = 3; pass >= 0; --pass) {
        const int shift = 8 * pass;
        if (tid < 256) hist[tid] = 0u;
        __syncthreads();
        for (int i = tid; i < n; i += NTHREADS) { const unsigned v = sv[i]; if ((v & mask) == prefix) atomicAdd((unsigned*)&hist[(v >> shift) & 255u], 1u); }
        __syncthreads();
        if (tid < 64) {
            const int c0 = (int)hist[255 - 4 * tid], c1 = (int)hist[254 - 4 * tid], c2 = (int)hist[253 - 4 * tid], c3 = (int)hist[252 - 4 * tid];
            const int tot = c0 + c1 + c2 + c3; int incl = tot;
#pragma unroll
            for (int o = 1; o < 64; o <<= 1) { const int y = __shfl_up(incl, o); if (tid >= o) incl += y; }
            const int excl = incl - tot;
            if (excl < kth && kth <= incl) {
                int cum = excl, bsel, rem;
                if (cum + c0 >= kth) { bsel = 255 - 4 * tid; rem = kth - cum; }
                else { cum += c0; if (cum + c1 >= kth) { bsel = 254 - 4 * tid; rem = kth - cum; }
                else { cum += c1; if (cum + c2 >= kth) { bsel = 253 - 4 * tid; rem = kth - cum; }
                else { cum += c2; bsel = 252 - 4 * tid; rem = kth - cum; } } }
                misc[0] = bsel; misc[1] = rem;
            }
        }
        __syncthreads();
        prefix |= (unsigned)misc[0] << shift; kth = misc[1]; mask |= 0xffu << shift;
        __syncthreads();
    }
    const unsigned T = prefix; const int need_eq = kth;
    const int per = (n + NTHREADS - 1) / NTHREADS, i0 = tid * per, i1 = (i0 + per < n) ? i0 + per : n;
    int cgt = 0, ceq = 0;
    for (int i = i0; i < i1; ++i) { const unsigned v = sv[i]; cgt += (v > T); ceq += (v == T); }
    const int eq_before = block_excl_scan(ceq, tmp, tid);
    int myeq = need_eq - eq_before; myeq = myeq < 0 ? 0 : (myeq > ceq ? ceq : myeq);
    int slot = block_excl_scan(cgt + myeq, tmp, tid);
    int eqr = eq_before;
    for (int i = i0; i < i1; ++i) {
        const unsigned v = sv[i]; bool sel = v > T;
        if (v == T) { sel = eqr < need_eq; ++eqr; }
        if (sel) { const int rs = slot0 + slot; IDX[e * EROWS + rs] = row0 + i; GATE[e * EROWS + rs] = __uint_as_float(v); INV[(size_t)(row0 + i) * 16 + e] = rs; ++slot; }
        else INV[(size_t)(row0 + i) * 16 + e] = -1;
    }
}
__device__ __forceinline__ void phase_select(const Params& p, LAS unsigned char* lds, bool with_ctx) {
    unsigned char* ws = launder(p.ws);
    const float* AFF = (const float*)(ws + WS_AFF); int* IDX = (int*)(ws + WS_IDX); float* GATE = (float*)(ws + WS_GATE); int* INV = (int*)(ws + WS_INV);
    const int nitems = with_ctx ? 64 : 32;
    for (int it = blockIdx.x; it < nitems; it += gridDim.x) {
        if (it < 32) { const int b = it >> 4, e = it & 15;
            topk_select(AFF + (size_t)(b * 16 + e) * SEQ, SEQ, CAPL, e, b * CAPL, b * SEQ, IDX, GATE, INV, lds);
            if (b == 0) for (int i = 2 * CAPL + 2 * CAPC + opaque_tid(); i < EROWS; i += NTHREADS) { IDX[e * EROWS + i] = -1; GATE[e * EROWS + i] = 0.f; }
            if (b == 1 && !with_ctx) for (int i = 2 * CAPL + opaque_tid(); i < 2 * CAPL + 2 * CAPC; i += NTHREADS) { IDX[e * EROWS + i] = -1; GATE[e * EROWS + i] = 0.f; }
        } else { const int b = (it - 32) >> 4, e = it & 15;
            topk_select(AFF + (size_t)2 * 16 * SEQ + (size_t)(b * 16 + e) * CTXL, CTXL, CAPC, e, 2 * CAPL + b * CAPC, MLAT + b * CTXL, IDX, GATE, INV, lds); }
    }
}
__device__ __forceinline__ void phase_gather(const Params& p, int rows_per_e) {
    const int tid = opaque_tid(), lane = tid & 63, wave = tid >> 6;
    unsigned char* ws = launder(p.ws);
    const int* IDX = (const int*)(ws + WS_IDX); const bf16_raw* H2 = (const bf16_raw*)(ws + WS_H2); bf16_raw* XG = (bf16_raw*)(ws + WS_XG);
    const int gw = blockIdx.x * NWAVES + wave, NGW = gridDim.x * NWAVES, total = NEXP * rows_per_e;
    for (int i0 = gw; i0 < total; i0 += 4 * NGW) {
        int src[4]; size_t dsto[4];
#pragma unroll
        for (int k = 0; k < 4; ++k) { const int i = i0 + k * NGW; src[k] = -2; dsto[k] = 0;
            if (i < total) { const int e = i / rows_per_e, sl = i % rows_per_e; src[k] = IDX[e * EROWS + sl]; dsto[k] = ((size_t)e * EROWS + sl) * DM; } }
        u32x4_t a[4], c[4];
#pragma unroll
        for (int k = 0; k < 4; ++k) { a[k] = (u32x4_t){0u, 0u, 0u, 0u}; c[k] = a[k];
            if (src[k] >= 0) { a[k] = *(const u32x4_t*)(H2 + (size_t)src[k] * DM + 8 * lane); c[k] = *(const u32x4_t*)(H2 + (size_t)src[k] * DM + 512 + 8 * lane); } }
#pragma unroll
        for (int k = 0; k < 4; ++k) if (src[k] != -2) { *(u32x4_t*)(XG + dsto[k] + 8 * lane) = a[k]; *(u32x4_t*)(XG + dsto[k] + 512 + 8 * lane) = c[k]; }
    }
}
template <bool FINAL>
__device__ __forceinline__ void phase_combine(const Params& p, int layer) {
    const int tid = opaque_tid(), lane = tid & 63, wave = tid >> 6;
    unsigned char* ws = launder(p.ws);
    const float* XA = (const float*)(ws + WS_XA); float* XB = (float*)(ws + WS_XB); const int* INV = (const int*)(ws + WS_INV);
    const bf16_raw* YE = (const bf16_raw*)(ws + WS_YE); const float* MOD = (const float*)(ws + WS_MOD); bf16_raw* H = (bf16_raw*)(ws + WS_H);
    const int gw = blockIdx.x * NWAVES + wave, NGW = gridDim.x * NWAVES, nrows = FINAL ? MLAT : MALL;
    f32x4_t v[4], vn[4]; int myinv = -1, myinvn = -1;
    u32x2_t w0[4], w1[4], w2[4], w3[4]; float f0 = 0.f, f1 = 0.f, f2 = 0.f, f3 = 0.f; unsigned long long mask = 0ull;
#define COMB_FIRST_PAIR(INVV) do { mask = __ballot((INVV) >= 0) & 0xffffull; f0 = 0.f; f1 = 0.f; f2 = 0.f; f3 = 0.f; int e0_ = 0, e1_, e2_, e3_; \
        if (mask) { e0_ = __builtin_ctzll(mask); mask &= mask - 1; f0 = 1.f; } e1_ = e0_; \
        if (mask) { e1_ = __builtin_ctzll(mask); mask &= mask - 1; f1 = 1.f; } e2_ = e0_; \
        if (mask) { e2_ = __builtin_ctzll(mask); mask &= mask - 1; f2 = 1.f; } e3_ = e0_; \
        if (mask) { e3_ = __builtin_ctzll(mask); mask &= mask - 1; f3 = 1.f; } \
        const int s0_ = __shfl((INVV), e0_), s1_ = __shfl((INVV), e1_), s2_ = __shfl((INVV), e2_), s3_ = __shfl((INVV), e3_); \
        const bf16_raw* y0_ = YE + ((size_t)e0_ * EROWS + (s0_ < 0 ? 0 : s0_)) * DM; const bf16_raw* y1_ = YE + ((size_t)e1_ * EROWS + (s1_ < 0 ? 0 : s1_)) * DM; \
        const bf16_raw* y2_ = YE + ((size_t)e2_ * EROWS + (s2_ < 0 ? 0 : s2_)) * DM; const bf16_raw* y3_ = YE + ((size_t)e3_ * EROWS + (s3_ < 0 ? 0 : s3_)) * DM; \
        _Pragma("unroll") for (int j = 0; j < 4; ++j) { w0[j] = __builtin_nontemporal_load((const u32x2_t*)(y0_ + 4 * lane + 256 * j)); w1[j] = __builtin_nontemporal_load((const u32x2_t*)(y1_ + 4 * lane + 256 * j)); \
                                                        w2[j] = __builtin_nontemporal_load((const u32x2_t*)(y2_ + 4 * lane + 256 * j)); w3[j] = __builtin_nontemporal_load((const u32x2_t*)(y3_ + 4 * lane + 256 * j)); } } while (0)
    for (int part = 0; part < (FINAL ? 1 : 2); ++part) {
        const int rbeg = part == 0 ? gw * 8 : MLAT + gw, rend = part == 0 ? rbeg + 8 : (gw < MALL - MLAT ? rbeg + 1 : rbeg);
        if (rbeg >= rend) break;
        const int vsel = part == 0 ? (rbeg >> 13) : 2;
        const float* gt2 = MOD + (size_t)(layer * 3 + vsel) * 6144 + 5120;
        f32x4_t gate4[4], gm[4], sh[4];
#pragma unroll
        for (int j = 0; j < 4; ++j) gate4[j] = *(const f32x4_t*)(gt2 + 4 * lane + 256 * j);
        if (!FINAL) norm_modvec(p.in[I_NMIX] + 1024, MOD + (size_t)(3 + vsel) * 6144, lane, gm, sh);
        int r = rbeg;
#pragma unroll
        for (int j = 0; j < 4; ++j) v[j] = __builtin_nontemporal_load((const f32x4_t*)(XA + (size_t)r * DM + 4 * lane + 256 * j));
        myinv = (lane < 16) ? INV[(size_t)r * 16 + lane] : -1;
        COMB_FIRST_PAIR(myinv);
        for (; r < rend; ++r) {
            const int rn = r + 1;
            if (rn < rend) {
#pragma unroll
                for (int j = 0; j < 4; ++j) vn[j] = __builtin_nontemporal_load((const f32x4_t*)(XA + (size_t)rn * DM + 4 * lane + 256 * j));
                myinvn = (lane < 16) ? INV[(size_t)rn * 16 + lane] : -1; }
            f32x4_t acc[4];
#pragma unroll
            for (int j = 0; j < 4; ++j) {
                acc[j].x = f0 * bf2f(w0[j].x & 0xffffu) + f1 * bf2f(w1[j].x & 0xffffu); acc[j].y = f0 * bf2f(w0[j].x >> 16) + f1 * bf2f(w1[j].x >> 16);
                acc[j].z = f0 * bf2f(w0[j].y & 0xffffu) + f1 * bf2f(w1[j].y & 0xffffu); acc[j].w = f0 * bf2f(w0[j].y >> 16) + f1 * bf2f(w1[j].y >> 16);
                acc[j].x += f2 * bf2f(w2[j].x & 0xffffu); acc[j].y += f2 * bf2f(w2[j].x >> 16); acc[j].z += f2 * bf2f(w2[j].y & 0xffffu); acc[j].w += f2 * bf2f(w2[j].y >> 16);
                acc[j].x += f3 * bf2f(w3[j].x & 0xffffu); acc[j].y += f3 * bf2f(w3[j].x >> 16); acc[j].z += f3 * bf2f(w3[j].y & 0xffffu); acc[j].w += f3 * bf2f(w3[j].y >> 16); }
            while (mask) {
                const int e0 = __builtin_ctzll(mask); mask &= mask - 1;
                int e1 = -1; if (mask) { e1 = __builtin_ctzll(mask); mask &= mask - 1; }
                const bf16_raw* y0 = YE + ((size_t)e0 * EROWS + __shfl(myinv, e0)) * DM;
                const bf16_raw* y1 = YE + ((size_t)(e1 < 0 ? e0 : e1) * EROWS + __shfl(myinv, e1 < 0 ? e0 : e1)) * DM;
                u32x2_t x0[4], x1[4];
#pragma unroll
                for (int j = 0; j < 4; ++j) { x0[j] = *(const u32x2_t*)(y0 + 4 * lane + 256 * j); x1[j] = *(const u32x2_t*)(y1 + 4 * lane + 256 * j); }
                const float g1 = e1 < 0 ? 0.f : 1.f;
#pragma unroll
                for (int j = 0; j < 4; ++j) {
                    acc[j].x += bf2f(x0[j].x & 0xffffu); acc[j].y += bf2f(x0[j].x >> 16); acc[j].z += bf2f(x0[j].y & 0xffffu); acc[j].w += bf2f(x0[j].y >> 16);
                    acc[j].x += g1 * bf2f(x1[j].x & 0xffffu); acc[j].y += g1 * bf2f(x1[j].x >> 16); acc[j].z += g1 * bf2f(x1[j].y & 0xffffu); acc[j].w += g1 * bf2f(x1[j].y >> 16); }
            }
            if (rn < rend) COMB_FIRST_PAIR(myinvn);
#pragma unroll
            for (int j = 0; j < 4; ++j) v[j] = v[j] + gate4[j] * acc[j];
            if (FINAL) {
#pragma unroll
                for (int j = 0; j < 4; ++j) __builtin_nontemporal_store(v[j], (f32x4_t*)(p.out + (size_t)r * DM + 4 * lane + 256 * j));
            } else {
#pragma unroll
                for (int j = 0; j < 4; ++j) __builtin_nontemporal_store(v[j], (f32x4_t*)(XB + (size_t)r * DM + 4 * lane + 256 * j));
                norm_apply2(v, gm, sh);
                store_h(v, H + (size_t)r * DM, lane);
            }
#pragma unroll
            for (int j = 0; j < 4; ++j) v[j] = vn[j];
            myinv = myinvn;
        }
    }
#undef COMB_FIRST_PAIR
}

__device__ __forceinline__ void phase_prep1(const Params& p) {
    const int tid = opaque_tid(), lane = tid & 63, wave = tid >> 6;
    unsigned char* ws = launder(p.ws);
    const bf16_raw* P = (const bf16_raw*)(ws + WS_P);
    bf16_raw* QC = (bf16_raw*)(ws + WS_QA); bf16_raw* KC = (bf16_raw*)(ws + WS_KA); bf16_raw* VC = (bf16_raw*)(ws + WS_VA);
    const f32x2_t* tab = (const f32x2_t*)(ws + WS_ROPE) + 128 * 16;
    const int gw = blockIdx.x * NWAVES + wave, NGW = gridDim.x * NWAVES;
    const int hl0 = 16 * (lane & 7);
    float qn[16], kn[16];
#pragma unroll
    for (int e = 0; e < 16; ++e) { qn[e] = p.in[I_QNC][hl0 + e]; kn[e] = p.in[I_KNC][hl0 + e]; }
    u32x4_t q0, q1, k0, k1, nq0 = {0u, 0u, 0u, 0u}, nq1 = nq0, nk0 = nq0, nk1 = nq0;
#define PREP1_LOAD(rr, Q0, Q1, K0, K1) do { const bf16_raw* prow = P + (size_t)(rr) * NC; if ((rr) < MLAT) { Q0 = __builtin_nontemporal_load((const u32x4_t*)(prow + 16 * lane)); Q1 = __builtin_nontemporal_load((const u32x4_t*)(prow + 16 * lane + 8)); } \
        K0 = __builtin_nontemporal_load((const u32x4_t*)(prow + 1024 + 16 * (lane & 31))); K1 = __builtin_nontemporal_load((const u32x4_t*)(prow + 1024 + 16 * (lane & 31) + 8)); } while (0)
    int r = gw;
    q0 = nq0; q1 = nq0; k0 = nq0; k1 = nq0;
    float cs[16], sn[16], ncs[16], nsn[16];
#pragma unroll
    for (int e = 0; e < 16; ++e) { cs[e] = 1.f; sn[e] = 0.f; ncs[e] = 1.f; nsn[e] = 0.f; }
    if (r < MALL) { PREP1_LOAD(r, q0, q1, k0, k1); if (r < MLAT) rope_cs<16, 32>(tab, hl0, r & 8191, cs, sn); }
    for (; r < MALL; r += NGW) {
        const int rn = r + NGW;
        if (rn < MALL) { PREP1_LOAD(rn, nq0, nq1, nk0, nk1); if (rn < MLAT) rope_cs<16, 32>(tab, hl0, rn & 8191, ncs, nsn); }
        const bool isctx = r >= MLAT; const int rc = isctx ? r - MLAT : r;
        const int b = isctx ? (rc >> 8) : (rc >> 13), t = isctx ? (rc & 255) : (rc & 8191);
        if (!isctx) {
            float x[16]; unpack8(q0, x); unpack8(q1, x + 8);
            float ss = 0.f;
#pragma unroll
            for (int e = 0; e < 16; ++e) ss += x[e] * x[e];
            ss += __shfl_xor(ss, 1); ss += __shfl_xor(ss, 2); ss += __shfl_xor(ss, 4);
            const float rms = rsqrtf(ss * (1.f / 128.f) + EPS);
#pragma unroll
            for (int e = 0; e < 16; ++e) x[e] = x[e] * rms * qn[e];
            rope_apply<16, 32>(x, hl0, cs, sn);
            *(u32x4_t*)(QC + (size_t)r * DM + 16 * lane) = pack8(x); *(u32x4_t*)(QC + (size_t)r * DM + 16 * lane + 8) = pack8(x + 8);
        }
        {
            float x[16]; unpack8(k0, x); unpack8(k1, x + 8);
            float ss = 0.f;
#pragma unroll
            for (int e = 0; e < 16; ++e) ss += x[e] * x[e];
            ss += __shfl_xor(ss, 1); ss += __shfl_xor(ss, 2); ss += __shfl_xor(ss, 4);
            const float rms = rsqrtf(ss * (1.f / 128.f) + EPS);
#pragma unroll
            for (int e = 0; e < 16; ++e) x[e] = x[e] * rms * kn[e];
            if (!isctx) rope_apply<16, 32>(x, hl0, cs, sn);
            const size_t dst = ((size_t)b * TALL + (isctx ? t : CTXL + t)) * 256;
            if (lane < 16) { *(u32x4_t*)(KC + dst + 16 * lane) = pack8(x); *(u32x4_t*)(KC + dst + 16 * lane + 8) = pack8(x + 8); }
            else if (lane < 32) { *(u32x4_t*)(VC + dst + 16 * (lane - 16)) = k0; *(u32x4_t*)(VC + dst + 16 * (lane - 16) + 8) = k1; }
        }
        q0 = nq0; q1 = nq1; k0 = nk0; k1 = nk1;
#pragma unroll
        for (int e = 0; e < 16; ++e) { cs[e] = ncs[e]; sn[e] = nsn[e]; }
    }
#undef PREP1_LOAD
}

#ifndef STOP_PHASE
#define STOP_PHASE 99
#endif
#ifndef PROBE
#define PROBE 0
#endif
#ifndef MOE_GATHER_FUSED
#define MOE_GATHER_FUSED 1
#endif
#ifndef BG_ON
#define BG_ON 1
#endif
constexpr int BG_S1_N = 3, BG_S2_N = 0, BG_S3_N = 5, BG_S4_N = 8, BG_S0_N = 4, BG_S5_N = 4, BG_S6_N = 8, BG_S7_N = 1;
constexpr int BG_S1_BASE = 0, BG_S2_BASE = BG_S1_BASE + BG_S1_N * (256 - 16 * SCAN_NSPLIT), BG_S3_BASE = BG_S2_BASE + BG_S2_N * 256, BG_S4_BASE = BG_S3_BASE + BG_S3_N * 192;
constexpr int BG_S0_BASE = BG_S4_BASE + BG_S4_N * 116, BG_S5_BASE = BG_S0_BASE + BG_S0_N * 224;
constexpr int BG_S6_BASE = BG_S5_BASE + BG_S5_N * 224;
constexpr int BG_S7_BASE = BG_S6_BASE + BG_S6_N * 42;
constexpr int BG_END = BG_S7_BASE + BG_S7_N * 224;
#define REP(k) for (int rep_ = 0; rep_ < ((PROBE == (k)) ? 2 : 1); ++rep_)
__device__ __forceinline__ void copy_out(const Params& p, const float* src) {
    const size_t n4 = (size_t)MLAT * DM / 4;
    for (size_t i = (size_t)blockIdx.x * NTHREADS + opaque_tid(); i < n4; i += (size_t)gridDim.x * NTHREADS) ((f32x4_t*)p.out)[i] = ((const f32x4_t*)src)[i];
}
#define GSYNC() xcd_barrier(xbar)
__device__ __forceinline__ void moe_block(const Params& p, LAS unsigned char* lds, const XcdBarrier& xbar, int layer, bool with_ctx) {
    unsigned char* ws = launder(p.ws); const int G = gridDim.x, bid = blockIdx.x;
    const bf16_raw* W1 = (const bf16_raw*)(ws + WS_W1) + (size_t)layer * NEXP * 4096 * 1024;
    const bf16_raw* W2 = (const bf16_raw*)(ws + WS_W2) + (size_t)layer * NEXP * 1024 * 2048;
    bf16_raw* XG = (bf16_raw*)(ws + WS_XG); bf16_raw* HID = (bf16_raw*)(ws + WS_HID); bf16_raw* YE = (bf16_raw*)(ws + WS_YE);
    const int nMt = with_ctx ? 9 : 8;
    phase_select(p, lds, with_ctx);
    if (BG_ON && with_ctx && bid >= 64) tr_items(p, lds, 1, BG_S3_BASE + (bid - 64), G - 64, BG_S3_N);
    if (BG_ON && !with_ctx && bid >= 32) tr_items(p, lds, 1, BG_S5_BASE + (bid - 32), G - 32, BG_S5_N);
    GSYNC();
    if (PROBE == 50 && with_ctx) { phase_select(p, lds, with_ctx); GSYNC(); }
    if (PROBE == 52 && with_ctx) { if (bid >= 64) tr_items(p, lds, 1, BG_S3_BASE + (bid - 64), G - 64, BG_S3_N); GSYNC(); }
    if (PROBE == 53 && with_ctx) { phase_select(p, lds, with_ctx); if (bid >= 64) tr_items(p, lds, 1, BG_S3_BASE + (bid - 64), G - 64, BG_S3_N); GSYNC(); }
#if MOE_GATHER_FUSED
    { pg8::Gemm g{(const bf16_raw*)(ws + WS_H2), W1, NEXP * EROWS, NEXP * 4096, 1024, (const int*)(ws + WS_IDX)}; pg8::MoeOrder S; S.init(nMt, 16, G, bid); pg8::EpiSwiglu E{HID};
      pg8::gemm_phase<pg8::EpiSwiglu, pg8::MoeOrder, true, true, true>(lds, g, S, E); }
#else
    phase_gather(p, with_ctx ? EROWS : 2 * CAPL); GSYNC();
    { pg8::Gemm g{XG, W1, NEXP * EROWS, NEXP * 4096, 1024}; pg8::MoeOrder S; S.init(nMt, 16, G, bid); pg8::EpiSwiglu E{HID};
      pg8::gemm_phase<pg8::EpiSwiglu, pg8::MoeOrder, true, true>(lds, g, S, E); }
#endif
    GSYNC();
    { pg8::Gemm g{HID, W2, NEXP * EROWS, NEXP * 1024, 2048}; pg8::MoeOrder S; S.init(8, 4, G, bid); pg8::EpiDown E{YE, (const float*)(ws + WS_GATE)};
      pg8::gemm_phase<pg8::EpiDown, pg8::MoeOrder, true, true>(lds, g, S, E);
      if (with_ctx) for (int t = bid; t < NEXP * 32; t += G) { const int e = t >> 5;
          moe2_ctx_piece(HID + (size_t)e * EROWS * FF, W2 + (size_t)e * 1024 * 2048, (const float*)(ws + WS_GATE) + e * EROWS, YE + (size_t)e * EROWS * DM, t & 31, lds); } }
    GSYNC();
}

__global__ void __launch_bounds__(NTHREADS, 2) mega(Params p) {
    extern __shared__ __attribute__((aligned(16))) unsigned char lds_raw[];
    LAS unsigned char* lds = (LAS unsigned char*)lds_raw;
    __builtin_assume(__builtin_amdgcn_workitem_id_y() == 0); __builtin_assume(__builtin_amdgcn_workitem_id_z() == 0);
    cg::grid_group grid = cg::this_grid();
    const int G = gridDim.x, bid = blockIdx.x;
    volatile LAS unsigned* xst = (volatile LAS unsigned*)(lds + LDS_BYTES - 16);
    if (opaque_tid() < 4) xst[opaque_tid()] = 0u;
    __syncthreads();
    const XcdBarrier xbar = xcd_barrier_post((unsigned*)launder(p.ws) + WS_CTL / 4, xst);
    unsigned char* ws = launder(p.ws);
    float* MOD = (float*)(ws + WS_MOD);
    bf16_raw* H = (bf16_raw*)(ws + WS_H); bf16_raw* H2 = (bf16_raw*)(ws + WS_H2);
    float* XA = (float*)(ws + WS_XA); float* XB = (float*)(ws + WS_XB);
    bf16_raw* P = (bf16_raw*)(ws + WS_P); bf16_raw* OAB = (bf16_raw*)(ws + WS_OAB);
    float* AFF = (float*)(ws + WS_AFF);

    if (p.ws == nullptr) grid.sync();
    REP(1) { phase_prep_weights(p, lds, BG_ON ? BG_END : 0); GSYNC(); }
    if (PROBE == 21) { phase_prep_weights(p, lds, -1); GSYNC(); }
    if (PROBE == 2) { for (int k = 0; k < 20; ++k) GSYNC(); }
    if (PROBE == 8) {
        const f32x4_t* src = (const f32x4_t*)p.in[I_WG]; u32x2_t* dst = (u32x2_t*)(ws + WS_HID);
        const size_t n4 = (size_t)2 * 16 * 1024 * 2048 / 4;
        for (size_t i = (size_t)bid * NTHREADS + opaque_tid(); i < n4; i += (size_t)G * NTHREADS) { const f32x4_t v = src[i]; u32x2_t w; w.x = pk2(v.x, v.y); w.y = pk2(v.z, v.w); dst[i] = w; }
        GSYNC();
    }
    REP(10) { phase_norm<1>(p.in[I_X], p.in[I_CTX], MALL, p.in[I_NMIX], MOD, H, p.in[I_WINAB] + NAB, LDW_AB, (float*)(ws + WS_AB), lds); GSYNC(); }
    REP(11) { { pg8::Gemm g{H, (const bf16_raw*)(ws + WS_WINAB), MALL, NAB, 1024}; pg8::StaticOrder S; S.init(MALL, NAB, G, bid); pg8::EpiBf16<0> E{P, NAB, nullptr, 0, 0, 1.f};
      pg8::gemm_phase<pg8::EpiBf16<0>, pg8::StaticOrder, true, true>(lds, g, S, E);
      if (BG_ON && bid >= 214) tr_items(p, lds, 1, BG_S6_BASE + (bid - 214), G - 214, BG_S6_N); }
    GSYNC(); }
    REP(7) { phase_bprep(p, lds); if (bid >= 32) { phase_prep0(p, bid - 32, G - 32); if (BG_ON) tr_items(p, lds, 1, BG_S0_BASE + (bid - 32), G - 32, BG_S0_N); } GSYNC(); }
    if (PROBE == 71) { if (bid >= 32) phase_prep0(p, bid - 32, G - 32); GSYNC(); }
    if (PROBE == 72) { if (bid >= 32) tr_items(p, lds, 1, BG_S0_BASE + (bid - 32), G - 32, BG_S0_N); GSYNC(); }
    if (PROBE == 73) { phase_prep0(p, bid, G); GSYNC(); }
    {
        if (bid < 16 * SCAN_NSPLIT) scan_chain<0>(p, lds, (bid & 7) + 8 * (bid / (8 * SCAN_NSPLIT)), (bid >> 3) & (SCAN_NSPLIT - 1));
        if (BG_ON && bid >= 16 * SCAN_NSPLIT) tr_items(p, lds, 1, BG_S1_BASE + (bid - 16 * SCAN_NSPLIT), G - 16 * SCAN_NSPLIT, BG_S1_N);
        unsigned* qctr = (unsigned*)(ws + WS_CTL) + 4000;
        volatile LAS int* qslot = (volatile LAS int*)(lds + LDS_BYTES - 32);
        int unext = 0;
        if (opaque_tid() == 0) unext = (int)__hip_atomic_fetch_add(qctr, 1u, __ATOMIC_RELAXED, __HIP_MEMORY_SCOPE_AGENT);
        for (;;) {
            __syncthreads();
            if (opaque_tid() == 0) qslot[0] = unext;
            __syncthreads();
            const int u = qslot[0];
            if (u >= 528) break;
            if (opaque_tid() == 0) unext = (int)__hip_atomic_fetch_add(qctr, 1u, __ATOMIC_RELAXED, __HIP_MEMORY_SCOPE_AGENT);
            if (u < 512) { const int b = u >> 8, kvh = (u >> 7) & 1, qb = u & 127; attnA_unit(p, lds, b, kvh, b * SEQ + qb * 64, qb * 64, true); }
            else { const int uc = u - 512, b = uc >> 3, kvh = (uc >> 2) & 1, qb = uc & 3; attnA_unit(p, lds, b, kvh, MLAT + b * CTXL + qb * 64, qb * 64, false); }
        }
    }
    GSYNC();
    if (PROBE == 43) { if (bid < 16 * SCAN_NSPLIT) scan_chain<1>(p, lds, (bid & 7) + 8 * (bid / (8 * SCAN_NSPLIT)), (bid >> 3) & (SCAN_NSPLIT - 1)); GSYNC(); }
    if (PROBE == 44) { if (bid < 16 * SCAN_NSPLIT) scan_chain<2>(p, lds, (bid & 7) + 8 * (bid / (8 * SCAN_NSPLIT)), (bid >> 3) & (SCAN_NSPLIT - 1)); GSYNC(); }
    if (PROBE == 45) { if (bid < 16 * SCAN_NSPLIT) scan_chain<3>(p, lds, (bid & 7) + 8 * (bid / (8 * SCAN_NSPLIT)), (bid >> 3) & (SCAN_NSPLIT - 1)); GSYNC(); }
    if (PROBE == 41) { if (bid < 16 * SCAN_NSPLIT) scan_chain<0>(p, lds, (bid & 7) + 8 * (bid / (8 * SCAN_NSPLIT)), (bid >> 3) & (SCAN_NSPLIT - 1)); GSYNC(); }
    if (PROBE == 42) { unsigned* qctr = (unsigned*)(ws + WS_CTL) + 4001; volatile LAS int* qslot = (volatile LAS int*)(lds + LDS_BYTES - 32);
        for (;;) { __syncthreads(); if (opaque_tid() == 0) qslot[0] = (int)__hip_atomic_fetch_add(qctr, 1u, __ATOMIC_RELAXED, __HIP_MEMORY_SCOPE_AGENT); __syncthreads();
            const int u = qslot[0]; if (u >= 528) break;
            if (u < 512) { const int b = u >> 8, kvh = (u >> 7) & 1, qb = u & 127; attnA_unit(p, lds, b, kvh, b * SEQ + qb * 64, qb * 64, true); }
            else { const int uc = u - 512, b = uc >> 3, kvh = (uc >> 2) & 1, qb = uc & 3; attnA_unit(p, lds, b, kvh, MLAT + b * CTXL + qb * 64, qb * 64, false); } }
        GSYNC(); }
    REP(12) { phase_outgate(p, lds); if (BG_ON && bid >= 32) tr_items(p, lds, 1, BG_S7_BASE + (bid - 32), G - 32, BG_S7_N); GSYNC(); }
    REP(13) { { pg8::Gemm g{OAB, (const bf16_raw*)(ws + WS_WOUTAB), MLAT, 1024, 1024}; pg8::StaticOrder S; S.init(MLAT, 1024, G, bid); pg8::EpiResid E{p.in[I_X], p.in[I_CTX], XA, MOD + 2048};
      pg8::gemm_phase<pg8::EpiResid, pg8::StaticOrder, true, true>(lds, g, S, E);
      for (int t = bid; t < 256; t += G) mini_resid_tile(OAB + (size_t)MLAT * DM, (const bf16_raw*)(ws + WS_WOUTAB), p.in[I_CTX], MOD + 2048 + 2 * 6144, XA + (size_t)MLAT * DM, (t >> 5) * 64, (t & 31) * 32, lds);
      if (BG_ON) tr_items(p, lds, 1, BG_S2_BASE + bid, G, BG_S2_N); }
    GSYNC(); }
    if (STOP_PHASE == 6) { copy_out(p, XA); return; }
    REP(14) { phase_norm<2>(XA, XA + (size_t)MLAT * DM, MALL, p.in[I_NFFN], MOD + 3072, H2, p.in[I_WR], 16, AFF, lds); GSYNC(); }
    moe_block(p, lds, xbar, 0, true);
    REP(15) { phase_combine<false>(p, 0); GSYNC(); }
    if (STOP_PHASE == 12) { copy_out(p, XB); return; }
    REP(16) { { pg8::Gemm g{H, (const bf16_raw*)(ws + WS_WINC), MALL, NC, 1024}; pg8::StaticOrder S; S.init(MALL, NC, G, bid); pg8::EpiBf16<0> E{P, NC, nullptr, 0, 0, 1.f};
      pg8::gemm_phase<pg8::EpiBf16<0>, pg8::StaticOrder, true, true>(lds, g, S, E);
      if (BG_ON && bid >= 140) tr_items(p, lds, 1, BG_S4_BASE + (bid - 140), G - 140, BG_S4_N); }
    GSYNC(); }
    REP(17) { phase_prep1(p); GSYNC(); }
    if (PROBE == 60) { for (int k = 0; k < 8; ++k) __builtin_amdgcn_s_sleep(127); }
    REP(6) {
        const attc::bf16* QC = (const attc::bf16*)(ws + WS_QA); const attc::bf16* KC = (const attc::bf16*)(ws + WS_KA); const attc::bf16* VC = (const attc::bf16*)(ws + WS_VA);
        for (int u = bid; u < 512; u += G) {
            const int qblk = u & 31, hh = (u >> 5) & 7, b = u >> 8;
            const size_t qoff = ((size_t)(b * SEQ + qblk * 256) * 8 + hh) * 128, koff = ((size_t)b * TALL * 2 + (hh >> 2)) * 128;
            int seq = TALL; asm volatile("" : "+s"(seq));
            attc::attn_dense_body<attc::bf16>(launder(QC + qoff), launder(KC + koff), launder(VC + koff), launder(OAB + qoff), seq, (char*)lds_raw);
            __syncthreads();
        }
    }
    GSYNC();
    REP(18) { { pg8::Gemm g{OAB, (const bf16_raw*)(ws + WS_WOUTC), MLAT, 1024, 1024}; pg8::StaticOrder S; S.init(MLAT, 1024, G, bid); pg8::EpiResid E{XB, XB + (size_t)MLAT * DM, XA, MOD + 3 * 6144 + 2048};
      pg8::gemm_phase<pg8::EpiResid, pg8::StaticOrder, true, true>(lds, g, S, E); }
    GSYNC(); }
    if (STOP_PHASE == 16) { copy_out(p, XA); return; }
    phase_norm<2>(XA, XA + (size_t)MLAT * DM, MLAT, p.in[I_NFFN] + 1024, MOD + 3 * 6144 + 3072, H2, p.in[I_WR] + 1024 * 16, 16, AFF, lds); GSYNC();
    REP(5) moe_block(p, lds, xbar, 1, false);
    phase_combine<true>(p, 1);
}

extern "C" void kernel_launch(void* const* d_in, const int* in_sizes, int n_in, void* d_out, int out_size, void* d_ws, size_t ws_size, hipStream_t stream) {
    static int grid_blocks = 0;
    if (grid_blocks == 0) {
        int dev = 0, cus = 0, per_cu = 0;
        if (n_in != 25 || out_size != MLAT * DM || ws_size < WS_END) { fprintf(stderr, "kernel_launch: unexpected shapes: n_in %d out %d ws %zu (need %zu)\n", n_in, out_size, ws_size, (size_t)WS_END); grid_blocks = -1; return; }
        (void)hipGetDevice(&dev);
        (void)hipDeviceGetAttribute(&cus, hipDeviceAttributeMultiprocessorCount, dev);
        if (hipFuncSetAttribute((const void*)mega, hipFuncAttributeMaxDynamicSharedMemorySize, LDS_BYTES) != hipSuccess) { fprintf(stderr, "hipFuncSetAttribute failed\n"); grid_blocks = -1; return; }
        (void)hipOccupancyMaxActiveBlocksPerMultiprocessor(&per_cu, (const void*)mega, NTHREADS, LDS_BYTES);
        if (per_cu < 1) { fprintf(stderr, "kernel_launch: occupancy query says 0 blocks per CU\n"); grid_blocks = -1; return; }
        if (cus != 256) { fprintf(stderr, "kernel_launch: built for a 256-CU device (static work split), found %d CUs; nothing launched\n", cus); grid_blocks = -1; return; }
        grid_blocks = cus;
    }
    if (grid_blocks < 0) return;
    if (hipMemsetAsync((char*)d_ws + WS_CTL, 0, CTL_BYTES, stream) != hipSuccess) { fprintf(stderr, "kernel_launch: hipMemsetAsync failed\n"); return; }
    Params p{};
    for (int i = 0; i < 25; ++i) p.in[i] = (const float*)d_in[i];
    p.out = (float*)d_out; p.ws = (unsigned char*)d_ws;
    void* args[] = {&p};
    hipError_t e = hipLaunchCooperativeKernel((const void*)mega, dim3(grid_blocks), dim3(NTHREADS), args, LDS_BYTES, stream);
    if (e != hipSuccess) fprintf(stderr, "cooperative launch failed: %s (grid %d)\n", hipGetErrorString(e), grid_blocks);
}
```
